# Optimizing an MI355X kernel written in HIP

```python
import math
import jax, jax.numpy as jnp
from jax import lax
import numpy as np

D_MODEL = 1024
BATCH = 16
SEQ = 2048
DEPTH = 2

N_META = 16
BLOCK = 128
PAD = BLOCK - N_META
HEAD_DIM = 64
A_HEADS = 8
A_KV_HEADS = 2
WINDOW = 128
B_HEADS = 4
B_QK_DIM = 32
B_V_DIM = 64
C_GROUPS = 4
C_GROUP_DIM = 64
POOL_WINDOWS = (2, 4, 8, 16)
N_BUCKETS = 32
MAX_DISTANCE = 128
N_BIAS_HEADS = A_HEADS + B_HEADS
D_FF = 2816
N_EXPERTS = 8
TOP_K = 2
D_FF_EXPERT = 3584
EPS = 1e-6
NEG = -1e30

A_Q = A_HEADS * HEAD_DIM
A_KV = A_KV_HEADS * HEAD_DIM
B_QK = B_HEADS * 2 * B_QK_DIM
B_V = B_HEADS * B_V_DIM
C_W = C_GROUPS * C_GROUP_DIM
D_IN = A_Q + 2 * A_KV + 2 * B_QK + B_V + C_W
D_MIX = A_Q + B_V + C_W
N_DENSE = (DEPTH + 1) // 2
N_MOE = DEPTH // 2

kernel_name = "hybrid_swa_diffattn_pool_moe"


def rmsnorm(x, g):
    xf = x.astype(jnp.float32)
    y = xf * lax.rsqrt(jnp.mean(xf * xf, axis=-1, keepdims=True) + EPS)
    return (y * g.astype(jnp.float32)).astype(x.dtype)


def t5_bucket(n):
    max_exact = N_BUCKETS // 2
    nf = jnp.maximum(n, 1).astype(jnp.float32)
    large = max_exact + (jnp.log(nf / max_exact) / math.log(MAX_DISTANCE / max_exact)
                         * (N_BUCKETS - max_exact)).astype(jnp.int32)
    large = jnp.minimum(large, N_BUCKETS - 1)
    return jnp.where(n < max_exact, n, large)


def pad_front(t):
    return jnp.pad(t, ((0, 0), (PAD, 0)) + ((0, 0),) * (t.ndim - 2))


def sliding_window_attention(q, k, v, sinks, table_a):
    B, Lp = q.shape[:2]
    nb = Lp // BLOCK
    g = A_HEADS // A_KV_HEADS
    qb = q.reshape(B, nb, BLOCK, A_KV_HEADS, g, HEAD_DIM)

    def band(t):
        tp = jnp.pad(t, ((0, 0), (BLOCK, 0), (0, 0), (0, 0)))
        tp = tp.reshape(B, nb + 1, BLOCK, A_KV_HEADS, HEAD_DIM)
        return jnp.concatenate([tp[:, :-1], tp[:, 1:]], axis=2)

    kb, vb = band(k), band(v)
    a_idx = jnp.arange(BLOCK)[:, None]
    b_idx = jnp.arange(2 * BLOCK)[None, :]
    n = BLOCK + a_idx - b_idx
    in_win = (n >= 0) & (n < WINDOW)
    blk = jnp.arange(nb)[:, None, None]
    key_ok = (blk - 1) * BLOCK + b_idx[None] >= PAD
    mask = in_win[None] & key_ok
    bias = table_a[t5_bucket(jnp.maximum(n, 0))]
    bias = jnp.transpose(bias, (2, 0, 1)).reshape(A_KV_HEADS, g, BLOCK, 2 * BLOCK)

    s = jnp.einsum('bnqhgd,bnkhd->bnhgqk', qb, kb).astype(jnp.float32) * (HEAD_DIM ** -0.5)
    s = s + bias[None, None].astype(jnp.float32)
    s = jnp.where(mask[None, :, None, None], s, NEG)
    sink = jnp.broadcast_to(sinks.astype(jnp.float32).reshape(1, 1, A_KV_HEADS, g, 1, 1),
                            s.shape[:-1] + (1,))
    p = jax.nn.softmax(jnp.concatenate([s, sink], axis=-1), axis=-1)[..., :-1]
    o = jnp.einsum('bnhgqk,bnkhd->bnqhgd', p.astype(v.dtype), vb)
    return o.reshape(B, Lp, A_Q)


def diff_attention(q, k, v, table_b, lam, g_out, lam_init):
    B, Lp = q.shape[:2]
    nb = Lp // BLOCK
    scale = B_QK_DIM ** -0.5
    outs = []
    for i in range(nb):
        q0, kend = i * BLOCK, (i + 1) * BLOCK
        qi, kk, vv = q[:, q0:kend], k[:, :kend], v[:, :kend]
        s = jnp.einsum('bqhcd,bkhcd->bhcqk', qi, kk).astype(jnp.float32) * scale
        qpos = q0 + jnp.arange(BLOCK)
        kpos = jnp.arange(kend)
        n = qpos[:, None] - kpos[None, :]
        bias = table_b[t5_bucket(jnp.maximum(n, 0))]
        s = s + jnp.transpose(bias, (2, 0, 1))[None, :, None].astype(jnp.float32)
        mask = (n >= 0) & (kpos[None, :] >= PAD)
        s = jnp.where(mask, s, NEG)
        p = jax.nn.softmax(s, axis=-1)
        a = p[:, :, 0] - lam * p[:, :, 1]
        outs.append(jnp.einsum('bhqk,bkhd->bqhd', a.astype(v.dtype), vv))
    o = jnp.concatenate(outs, axis=1)
    o = rmsnorm(o, g_out) * (1.0 - lam_init)
    return o.reshape(B, Lp, B_V)


def multiscale_pool(u, w_pool, pool_scale):
    B, L, _ = u.shape
    ug = u.reshape(B, L, C_GROUPS, C_GROUP_DIM)
    t = jnp.arange(L)
    pooled = []
    for gi, w in enumerate(POOL_WINDOWS):
        xg = ug[:, :, gi].astype(jnp.float32)
        cs = jnp.concatenate([jnp.zeros((B, 1, C_GROUP_DIM), jnp.float32),
                              jnp.cumsum(xg, axis=1)], axis=1)
        lo = jnp.maximum(t + 1 - w, 0)
        cnt = jnp.minimum(t + 1, w).astype(jnp.float32)
        mean = (cs[:, 1:] - cs[:, lo]) / cnt[None, :, None]
        pooled.append(mean - xg)
    d = jnp.stack(pooled, axis=2).astype(u.dtype)
    y = jnp.einsum('blgc,gcd->blgd', d, w_pool).reshape(B, L, C_W)
    return y * pool_scale


def swiglu(h, wg, wu, wd):
    return (jax.nn.silu(h @ wg) * (h @ wu)) @ wd


def moe_swiglu(h, w_router, w_gate, w_up, w_down):
    B, L, D = h.shape
    t = h.reshape(-1, D)
    logits = (t @ w_router).astype(jnp.float32)
    top_v, top_i = lax.top_k(logits, TOP_K)
    gates = jax.nn.softmax(top_v, axis=-1)
    combine = jnp.sum(jax.nn.one_hot(top_i, N_EXPERTS, dtype=jnp.float32) * gates[..., None], axis=1)
    out = jnp.zeros_like(t)
    for e in range(N_EXPERTS):
        ye = swiglu(t, w_gate[e], w_up[e], w_down[e])
        out = out + combine[:, e:e + 1].astype(t.dtype) * ye
    return out.reshape(B, L, D)


def setup_inputs(seed: int = 0) -> dict:
    key = jax.random.key(seed)
    ks = jax.random.split(key, 24)
    f32 = jnp.float32
    nrm = lambda k, s, sc: jax.random.normal(k, s, f32) * sc
    return {
        "x": nrm(ks[0], (BATCH, SEQ, D_MODEL), 1.0),
        "meta_tokens": nrm(ks[1], (N_META, D_MODEL), 1.0),
        "rel_bias_table": nrm(ks[2], (N_BUCKETS, N_BIAS_HEADS), 0.5),
        "g_mix": 1.0 + nrm(ks[3], (DEPTH, D_MODEL), 0.05),
        "w_in": nrm(ks[4], (DEPTH, D_MODEL, D_IN), D_MODEL ** -0.5),
        "qk_gain_a": 1.0 + nrm(ks[5], (DEPTH, 2, HEAD_DIM), 0.05),
        "sinks": nrm(ks[6], (DEPTH, A_HEADS), 0.5),
        "qk_gain_b": 1.0 + nrm(ks[7], (DEPTH, 2, B_QK_DIM), 0.05),
        "diff_lambda": nrm(ks[8], (DEPTH, 4, B_QK_DIM), 0.1),
        "g_diff_out": 1.0 + nrm(ks[9], (DEPTH, B_V_DIM), 0.05),
        "w_pool": nrm(ks[10], (DEPTH, C_GROUPS, C_GROUP_DIM, C_GROUP_DIM), C_GROUP_DIM ** -0.5),
        "pool_scale": 1.0 + nrm(ks[11], (DEPTH, C_W), 0.1),
        "w_out": nrm(ks[12], (DEPTH, D_MIX, D_MODEL), D_MIX ** -0.5),
        "g_ffn": 1.0 + nrm(ks[13], (DEPTH, D_MODEL), 0.05),
        "w_ffn_gate": nrm(ks[14], (N_DENSE, D_MODEL, D_FF), D_MODEL ** -0.5),
        "w_ffn_up": nrm(ks[15], (N_DENSE, D_MODEL, D_FF), D_MODEL ** -0.5),
        "w_ffn_down": nrm(ks[16], (N_DENSE, D_FF, D_MODEL), D_FF ** -0.5),
        "w_router": nrm(ks[17], (N_MOE, D_MODEL, N_EXPERTS), D_MODEL ** -0.5),
        "w_exp_gate": nrm(ks[18], (N_MOE, N_EXPERTS, D_MODEL, D_FF_EXPERT), D_MODEL ** -0.5),
        "w_exp_up": nrm(ks[19], (N_MOE, N_EXPERTS, D_MODEL, D_FF_EXPERT), D_MODEL ** -0.5),
        "w_exp_down": nrm(ks[20], (N_MOE, N_EXPERTS, D_FF_EXPERT, D_MODEL), D_FF_EXPERT ** -0.5),
    }


def reference(x, meta_tokens, rel_bias_table, g_mix, w_in, qk_gain_a, sinks, qk_gain_b,
              diff_lambda, g_diff_out, w_pool, pool_scale, w_out, g_ffn, w_ffn_gate,
              w_ffn_up, w_ffn_down, w_router, w_exp_gate, w_exp_up, w_exp_down):
    B = x.shape[0]
    meta = jnp.broadcast_to(meta_tokens[None].astype(x.dtype), (B, N_META, D_MODEL))
    h_res = jnp.concatenate([meta, x], axis=1)
    L = h_res.shape[1]
    table_a = rel_bias_table[:, :A_HEADS]
    table_b = rel_bias_table[:, A_HEADS:]
    splits = list(np.cumsum([A_Q, A_KV, A_KV, B_QK, B_QK, B_V]))
    for l in range(DEPTH):
        h = rmsnorm(h_res, g_mix[l])
        z = h @ w_in[l]
        qa, ka, va, qb, kb, vb, uc = jnp.split(z, splits, axis=-1)
        qa = rmsnorm(qa.reshape(B, L, A_HEADS, HEAD_DIM), qk_gain_a[l, 0])
        ka = rmsnorm(ka.reshape(B, L, A_KV_HEADS, HEAD_DIM), qk_gain_a[l, 1])
        va = va.reshape(B, L, A_KV_HEADS, HEAD_DIM)
        o_a = sliding_window_attention(pad_front(qa), pad_front(ka), pad_front(va),
                                       sinks[l], table_a)[:, PAD:]
        qb = rmsnorm(qb.reshape(B, L, B_HEADS, 2, B_QK_DIM), qk_gain_b[l, 0])
        kb = rmsnorm(kb.reshape(B, L, B_HEADS, 2, B_QK_DIM), qk_gain_b[l, 1])
        vb = vb.reshape(B, L, B_HEADS, B_V_DIM)
        lam_init = 0.8 - 0.6 * math.exp(-0.3 * l)
        dl = diff_lambda[l].astype(jnp.float32)
        lam = jnp.exp(jnp.sum(dl[0] * dl[1])) - jnp.exp(jnp.sum(dl[2] * dl[3])) + lam_init
        o_b = diff_attention(pad_front(qb), pad_front(kb), pad_front(vb), table_b, lam,
                             g_diff_out[l], lam_init)[:, PAD:]
        o_c = multiscale_pool(uc, w_pool[l], pool_scale[l])
        mix = jnp.concatenate([o_a.astype(h.dtype), o_b.astype(h.dtype), o_c.astype(h.dtype)], axis=-1)
        h_res = h_res + mix @ w_out[l]
        h = rmsnorm(h_res, g_ffn[l])
        if l % 2 == 0:
            j = l // 2
            f = swiglu(h, w_ffn_gate[j], w_ffn_up[j], w_ffn_down[j])
        else:
            j = l // 2
            f = moe_swiglu(h, w_router[j], w_exp_gate[j], w_exp_up[j], w_exp_down[j])
        h_res = h_res + f
    return h_res[:, N_META:]
```

```cpp
#include <hip/hip_runtime.h>
#include <cstdio>
#include <cstdint>

#define LAS __attribute__((address_space(3)))
#define GAS __attribute__((address_space(1)))
typedef unsigned short bf16_t;
typedef short bf16x8 __attribute__((ext_vector_type(8)));
typedef short s16x4 __attribute__((ext_vector_type(4)));
typedef float f32x2 __attribute__((ext_vector_type(2)));
typedef float f32x4 __attribute__((ext_vector_type(4)));
typedef float f32x16 __attribute__((ext_vector_type(16)));
typedef unsigned u32x2 __attribute__((ext_vector_type(2)));
typedef unsigned u32x4 __attribute__((ext_vector_type(4)));
typedef GAS unsigned gu32;

constexpr int D = 1024, NBATCH = 16, SEQ = 2048, M = NBATCH * SEQ, NMETA = 16;
constexpr int LP = 2176;
constexpr int PADP = 112;
constexpr int DIN = 1792, DFF = 2816, NE = 8, DFE = 3584;
constexpr int ZQA = 0, ZKA = 512, ZVA = 640, ZQB = 768, ZKB = 1024, ZVB = 1280, ZUC = 1536;
constexpr float EPS = 1e-6f, NEGF = -1e30f, LOG2E = 1.4426950408889634f;
constexpr int NWAVES = 8, NTHREADS = 512;

constexpr size_t MiB = 1u << 20;
constexpr size_t WS_CTL = 0, CTL_ZERO_BYTES = 96 * 1024;
constexpr size_t WS_WEGU = 1 * MiB;
constexpr size_t WS_WED = WS_WEGU + (size_t)NE * 2 * DFE * D;
constexpr size_t WS_HB8 = WS_WED + (size_t)NE * D * DFE;
constexpr size_t WS_MISC = WS_HB8 + (size_t)M * D;
constexpr size_t WS_R = WS_MISC + 10 * MiB;
constexpr size_t WS_HB = WS_R;
constexpr size_t WS_Z = WS_HB + (size_t)M * D * 2;
constexpr size_t Z_BYTES = (size_t)NBATCH * LP * DIN * 2;
constexpr size_t WS_MIX = WS_Z + ((Z_BYTES + MiB - 1) / MiB) * MiB;
constexpr size_t WS_WIN = WS_MIX + (size_t)M * D * 2;
constexpr size_t WS_WOUT = WS_WIN + (size_t)2 * DIN * D * 2;
constexpr size_t WS_WGU = WS_WOUT + (size_t)2 * D * D * 2;
constexpr size_t WS_WD = WS_WGU + (size_t)2 * DFF * D * 2;
constexpr size_t WS_ACT = WS_Z;
constexpr int ACTE_ROWS = M + NE * 256;
constexpr size_t ACTE_BYTES = (size_t)ACTE_ROWS * DFE;
constexpr size_t WS_ACTE = WS_Z;
constexpr size_t WS_PART = WS_ACTE + 2 * ACTE_BYTES;
constexpr size_t WS_END_A = WS_WD + (size_t)D * DFF * 2, WS_END_B = WS_PART + (size_t)224 * 65536 * 4;
constexpr size_t WS_END = WS_END_A > WS_END_B ? WS_END_A : WS_END_B;
static_assert(WS_ACT + (size_t)M * DFF * 2 <= WS_WIN, "dense hidden must not touch the converted weights");
constexpr int WEGU_SH = 5, WED_SH = 6, ACT_SH = 2;
constexpr size_t MS_SSP = 0;
constexpr size_t MS_LTOK = MS_SSP + (size_t)M * 16 * 4;
constexpr int LCAP = M + 256;
constexpr size_t MS_LGATE = MS_LTOK + (size_t)16 * LCAP * 4;
constexpr size_t MS_LRS = MS_LGATE + (size_t)16 * LCAP * 4;
constexpr size_t MS_HM = MS_LRS + (size_t)16 * LCAP * 4;
constexpr size_t MS_HMB = MS_HM + 16 * 1024 * 4;
constexpr size_t MS_SSPM = MS_HMB + 16 * 1024 * 2;
constexpr size_t MS_MIXM = MS_SSPM + 1024;
constexpr size_t MS_ACTM = MS_MIXM + 16 * 1024 * 2;
constexpr size_t MS_LUTA = MS_ACTM + 16 * 2816 * 2;
constexpr size_t MS_LUTB = MS_LUTA + 8 * 128 * 4;
constexpr size_t MS_WPT = MS_LUTB + 4 * 128 * 4;
constexpr size_t MS_WR = MS_WPT + 2 * 4 * 64 * 64 * 2;
constexpr size_t MS_END = MS_WR + 1024 * 8 * 4;
static_assert(MS_END <= 9 * MiB, "misc map");
constexpr int CW_BAR = 4096;
constexpr int CW_QUEUE = 16384;
constexpr int CW_CNT = 20480;
static_assert((CW_CNT + 64 * 32) * 4 <= (int)CTL_ZERO_BYTES && (CW_QUEUE + 64 * 24) <= CW_CNT, "control words inside the zeroed range");

__device__ __forceinline__ unsigned cvt_pk_bf16(float lo, float hi) { unsigned r; asm volatile("v_cvt_pk_bf16_f32 %0, %1, %2" : "=v"(r) : "v"(lo), "v"(hi)); return r; }
__device__ __forceinline__ unsigned pack4_fp8(float a, float b, float c, float d) { int w = 0; w = __builtin_amdgcn_cvt_pk_fp8_f32(a, b, w, false); w = __builtin_amdgcn_cvt_pk_fp8_f32(c, d, w, true); return (unsigned)w; }
__device__ __forceinline__ float bf16_lo(unsigned w) { return __uint_as_float(w << 16); }
__device__ __forceinline__ float bf16_hi(unsigned w) { return __uint_as_float(w & 0xffff0000u); }
template <int CTRL> __device__ __forceinline__ float dpp_mov(float v) { return __int_as_float(__builtin_amdgcn_update_dpp(0, __float_as_int(v), CTRL, 0xf, 0xf, true)); }
__device__ __forceinline__ float xor16_add(float v) { const auto r = __builtin_amdgcn_permlane16_swap(__float_as_uint(v), __float_as_uint(v), false, false); return __uint_as_float(r[0]) + __uint_as_float(r[1]); }
__device__ __forceinline__ float xor32_add(float v) { const auto r = __builtin_amdgcn_permlane32_swap(__float_as_uint(v), __float_as_uint(v), false, false); return __uint_as_float(r[0]) + __uint_as_float(r[1]); }
__device__ __forceinline__ float xor32_max(float v) { const auto r = __builtin_amdgcn_permlane32_swap(__float_as_uint(v), __float_as_uint(v), false, false); return fmaxf(__uint_as_float(r[0]), __uint_as_float(r[1])); }
__device__ __forceinline__ float wave_sum(float v) {
    v += dpp_mov<0xB1>(v);
    v += dpp_mov<0x4E>(v);
    v += dpp_mov<0x141>(v);
    v += dpp_mov<0x140>(v);
    return xor32_add(xor16_add(v));
}
#define LDS_WAIT() asm volatile("s_waitcnt lgkmcnt(0)" ::: "memory")
#define VM_WAIT() asm volatile("s_waitcnt vmcnt(0)" ::: "memory")
namespace pg8 {
constexpr int BM = 256, BK = 64, HALF = 128, HTB = HALF * BK * 2, STAGE_BYTES = 8 * HTB, NXCD = 8, WGM = 8;
constexpr int TOK_LDS_OFF = STAGE_BYTES;
constexpr int AUX_BUF = 4096;
constexpr int AUX_LDS_OFF = STAGE_BYTES + 1024;

__host__ __device__ __forceinline__ int lds_byte(int r, int c) { const int st = (r >> 4) * 2 + (c >> 5), rr = r & 15, cc = c & 31, ob = rr * 64 + cc * 2; return st * 1024 + (ob ^ (((ob >> 9) & 1) << 5)); }
__host__ __device__ __forceinline__ void stage_rc(int b, int& R, int& C) { const int st = b / 1024, sb = b % 1024, swz = sb ^ (((sb >> 9) & 1) << 5); R = (st >> 1) * 16 + swz / 64; C = (st & 1) * 32 + (swz % 64) / 2; }
__host__ __device__ __forceinline__ int perm32(int rho) { const int n = rho >> 4, i = rho & 15; return 8 * (i >> 2) + 4 * n + (i & 3); }

typedef int v8i32 __attribute__((ext_vector_type(8))); typedef int v4i32 __attribute__((ext_vector_type(4)));
__device__ __forceinline__ v8i32 cat8(bf16x8 a, bf16x8 b) { const v4i32 x = __builtin_bit_cast(v4i32, a), y = __builtin_bit_cast(v4i32, b); return __builtin_shufflevector(x, y, 0, 1, 2, 3, 4, 5, 6, 7); }
__device__ __forceinline__ void mfma_fp8(f32x4& acc, const v8i32& w, const v8i32& x, int sw, int sx) {
    asm volatile("s_nop 1\n\tv_mfma_scale_f32_16x16x128_f8f6f4 %0, %1, %2, %0, %3, %4 op_sel_hi:[0,0,0]" : "+v"(acc) : "v"(w), "v"(x), "v"(sw), "v"(sx));
}
__device__ __forceinline__ void mfma_fp8_z(f32x4& acc, const v8i32& w, const v8i32& x, int sw, int sx) {
    asm volatile("s_nop 1\n\tv_mfma_scale_f32_16x16x128_f8f6f4 %0, %1, %2, 0, %3, %4 op_sel_hi:[0,0,0]" : "=&v"(acc) : "v"(w), "v"(x), "v"(sw), "v"(sx));
}
struct Unit { int pm, pn, aux, kc, slab; };

template <int NN> __device__ __forceinline__ void order_map(int nM, int L, int& pm, int& pn) {
    const int nwg = nM * NN;
    int wgid = L; { const int q = nwg >> 3, r = nwg & 7, xcd = wgid & 7, off = wgid >> 3; wgid = (xcd < r ? xcd * (q + 1) : r * (q + 1) + (xcd - r) * q) + off; }
    constexpr int nig = WGM * NN; const int gid = wgid / nig, fm = gid * WGM, rem = wgid - gid * nig;
    if (fm + WGM <= nM) { pm = fm + (rem & (WGM - 1)); pn = rem / WGM; }
    else { pm = fm + rem / NN; pn = rem % NN; }
}
template <int NN> __device__ __forceinline__ bool static_order(int nM, int G, int c, int i, int& pm, int& pn) {
    const int L = i * G + c; if (L >= nM * NN) return false;
    order_map<NN>(nM, L, pm, pn); return true;
}

template <class Epi, class Sched>
__device__ __forceinline__ void gemm_phase(LAS unsigned char* lds, const int KB  , const Sched& S, const Epi& E) {
    const int tid = threadIdx.x, wid = __builtin_amdgcn_readfirstlane(tid >> 6), lane = tid & 63, wr = wid >> 2, wc = wid & 3, fr = lane & 15, fq = lane >> 4;
    const int nt = KB / 128;
    constexpr bool G = Sched::GATHER;
    unsigned voffB[2], aoC[2][2], aoN[2][2]; int rowA[2]; unsigned colA[2];
    const unsigned hstep = (unsigned)HALF * KB;
#pragma unroll
    for (int i = 0; i < 2; ++i) { int R, C; stage_rc(tid * 16 + i * 8192, R, C); const int Rb = (R & ~31) + perm32(R & 31);
        voffB[i] = (unsigned)(Rb * KB + C * 2); rowA[i] = R; colA[i] = (unsigned)C * 2u;
        aoC[0][i] = (unsigned)(R * KB + C * 2); aoC[1][i] = aoC[0][i] + hstep; aoN[0][i] = aoC[0][i]; aoN[1][i] = aoC[1][i]; }
    const size_t kstep = (size_t)(BK * 2);
    const unsigned ldsw = (unsigned)wid * 1024u;
    const int aoff = lds_byte(wr * 64 + fr, fq * 8), boff = lds_byte(wc * 32 + fr, fq * 8);
#define PG8_SA(b, h) (((b) * 2 + (h)) * HTB)
#define PG8_SB(b, h) ((4 + (b) * 2 + (h)) * HTB)
#define PG8_STAGE2(bufoff, gbase, o0, o1) do { \
        __builtin_amdgcn_global_load_lds((const unsigned*)((const char*)(gbase) + (o0)), (LAS unsigned*)(lds + (bufoff) + ldsw), 16, 0, 0); \
        __builtin_amdgcn_global_load_lds((const unsigned*)((const char*)(gbase) + (o1)), (LAS unsigned*)(lds + (bufoff) + ldsw + 8192), 16, 0, 0); } while (0)
#define PG8_STB(bufoff, gbase) PG8_STAGE2(bufoff, gbase, voffB[0], voffB[1])
#define PG8_LDA(dst, b, h) do { _Pragma("unroll") for (int m = 0; m < 4; ++m) { if constexpr (Sched::FP8) dst##8[m] = cat8(*(const LAS bf16x8*)(lds + PG8_SA(b, h) + aoff + m * 2048), *(const LAS bf16x8*)(lds + PG8_SA(b, h) + aoff + m * 2048 + 1024)); \
        else { _Pragma("unroll") for (int k = 0; k < 2; ++k) dst[m][k] = *(const LAS bf16x8*)(lds + PG8_SA(b, h) + aoff + m * 2048 + k * 1024); } } } while (0)
#define PG8_LDB(dst, b, h) do { _Pragma("unroll") for (int n = 0; n < 2; ++n) { if constexpr (Sched::FP8) dst##8[n] = cat8(*(const LAS bf16x8*)(lds + PG8_SB(b, h) + boff + n * 2048), *(const LAS bf16x8*)(lds + PG8_SB(b, h) + boff + n * 2048 + 1024)); \
        else { _Pragma("unroll") for (int k = 0; k < 2; ++k) dst[n][k] = *(const LAS bf16x8*)(lds + PG8_SB(b, h) + boff + n * 2048 + k * 1024); } } } while (0)
#define PG8_MMA(ai, bj, At, Bt, Z) do { __builtin_amdgcn_s_setprio(1); _Pragma("unroll") for (int m = 0; m < 4; ++m) _Pragma("unroll") for (int n = 0; n < 2; ++n) { \
        if constexpr (Sched::FP8) { if constexpr (Z) mfma_fp8_z(acc[ai][bj][m][n], Bt##8[n], At##8[m], scale_w, scale_x); else mfma_fp8(acc[ai][bj][m][n], Bt##8[n], At##8[m], scale_w, scale_x); } \
        else { _Pragma("unroll") for (int k = 0; k < 2; ++k) acc[ai][bj][m][n] = __builtin_amdgcn_mfma_f32_16x16x32_bf16(Bt[n][k], At[m][k], (Z && k == 0) ? (f32x4){0.f, 0.f, 0.f, 0.f} : acc[ai][bj][m][n], 0, 0, 0); } } __builtin_amdgcn_s_setprio(0); } while (0)
#define PG8_WAIT_V(n) asm volatile("s_waitcnt vmcnt(" #n ")" ::: "memory")
#define PG8_WAIT_L(n) asm volatile("s_waitcnt lgkmcnt(" #n ")" ::: "memory")
#define PG8_BAR __builtin_amdgcn_s_barrier()
#define PG8_SCHED __builtin_amdgcn_sched_barrier(0)
    Unit cur, nxt; int ui = 0;
    if (!S.next(0, cur)) return;
    int scale_w = Sched::SCALE_W, scale_x = Sched::SCALE_X; asm volatile("" : "+v"(scale_w), "+v"(scale_x));
    f32x4 acc[2][2][4][2];
#define PG8_ZERO_ACC do { if constexpr (!Sched::FP8) { _Pragma("unroll") for (int a = 0; a < 2; ++a) _Pragma("unroll") for (int b = 0; b < 2; ++b) _Pragma("unroll") for (int m = 0; m < 4; ++m) _Pragma("unroll") for (int n = 0; n < 2; ++n) { double z0, z1; asm volatile("v_mov_b64 %0, 0" : "=v"(z0)); asm volatile("v_mov_b64 %0, 0" : "=v"(z1)); const f32x2 p0 = __builtin_bit_cast(f32x2, z0), p1 = __builtin_bit_cast(f32x2, z1); acc[a][b][m][n] = (f32x4){p0[0], p0[1], p1[0], p1[1]}; } } } while (0)
    PG8_ZERO_ACC;
    bf16x8 At[4][2], B0[2][2], B1[2][2]; v8i32 At8[4], B08[2], B18[2];
    const char* cA = S.a_ptr(cur); const char* cB = S.b_ptr(cur);
    if constexpr (G) {
        const int* lp = S.list_ptr(cur); const int cnt = S.list_cnt(cur);
#pragma unroll
        for (int h = 0; h < 2; ++h)
#pragma unroll
            for (int i = 0; i < 2; ++i) { const int r = rowA[i] + HALF * h; const int id = r < cnt ? lp[r] : 0; aoC[h][i] = (unsigned)id * (unsigned)KB + colA[i]; }
    }
    if constexpr (Sched::AUX_OPS > 0) { if (wid >= 1 && wid <= Sched::AUX_OPS) __builtin_amdgcn_global_load_lds((const unsigned*)(S.aux_ptr(cur, wid - 1) + lane * 4), (LAS unsigned*)(lds + AUX_LDS_OFF + (wid - 1) * 1024), 16, 0, 0); }
    PG8_STB(PG8_SB(0, 0), cB); PG8_STB(PG8_SB(0, 1), cB + hstep); PG8_STAGE2(PG8_SA(0, 0), cA, aoC[0][0], aoC[0][1]); PG8_STAGE2(PG8_SA(0, 1), cA, aoC[1][0], aoC[1][1]);
    if (wr == 1) PG8_BAR;
    PG8_WAIT_V(2); PG8_BAR;
    PG8_STB(PG8_SB(1, 0), cB + kstep); PG8_STAGE2(PG8_SA(1, 0), cA + kstep, aoC[0][0], aoC[0][1]); PG8_STB(PG8_SB(1, 1), cB + hstep + kstep);
    PG8_WAIT_V(6); PG8_BAR;
    for (;;) {
        const bool has_next = S.next(ui + 1, nxt);
        int ntc = nt; if constexpr (Sched::VARK) ntc = S.nt_of(cur);
        const char* nA = has_next ? S.a_ptr(nxt) : cA; const char* nB = has_next ? S.b_ptr(nxt) : cB;
        int ncnt = 0;
        if constexpr (G) {
            if (has_next) { ncnt = S.list_cnt(nxt); if (wid == 0) __builtin_amdgcn_global_load_lds((const unsigned*)(S.list_ptr(nxt) + lane * 4), (LAS unsigned*)(lds + TOK_LDS_OFF), 16, 0, 0); }
        }
        if constexpr (Sched::AUX_OPS > 0) {
            if (has_next && wid >= 1 && wid <= Sched::AUX_OPS) __builtin_amdgcn_global_load_lds((const unsigned*)(S.aux_ptr(nxt, wid - 1) + lane * 4), (LAS unsigned*)(lds + AUX_LDS_OFF + ((ui + 1) % 3) * AUX_BUF + (wid - 1) * 1024), 16, 0, 0);
        }
#define PG8_TRIP(Z) do { \
            const bool last = (t == ntc - 2); \
            if constexpr (G) { \
                if (last && has_next) { \
                    const LAS int* tl = (const LAS int*)(lds + TOK_LDS_OFF); \
_Pragma("unroll") \
                    for (int h = 0; h < 2; ++h) \
_Pragma("unroll") \
                        for (int i = 0; i < 2; ++i) { const int r = rowA[i] + HALF * h; int id = tl[r]; id = r < ncnt ? id : 0; aoN[h][i] = (unsigned)id * (unsigned)KB + colA[i]; } \
                } else if (last) { \
_Pragma("unroll") \
                    for (int h = 0; h < 2; ++h) \
_Pragma("unroll") \
                        for (int i = 0; i < 2; ++i) aoN[h][i] = aoC[h][i]; \
                } \
            } \
            const char* a1 = cA + (size_t)(t + 1) * kstep; \
            const char* a2 = last ? nA : cA + (size_t)(t + 2) * kstep; const char* b2 = last ? nB : cB + (size_t)(t + 2) * kstep; \
            const char* a3 = a2 + kstep; const char* b3 = b2 + kstep; \
            unsigned o2[2][2]; \
_Pragma("unroll") \
            for (int h = 0; h < 2; ++h) \
_Pragma("unroll") \
                for (int i = 0; i < 2; ++i) o2[h][i] = (G && last) ? aoN[h][i] : aoC[h][i]; \
            PG8_LDB(B0, 0, 0); PG8_LDB(B1, 0, 1); PG8_SCHED; PG8_LDA(At, 0, 0); PG8_STAGE2(PG8_SA(1, 1), a1, aoC[1][0], aoC[1][1]); \
            PG8_WAIT_V(8); PG8_WAIT_L(0); PG8_BAR; PG8_MMA(0, 0, At, B0, Z); PG8_MMA(0, 1, At, B1, Z); PG8_BAR; PG8_SCHED; \
            PG8_LDA(At, 0, 1); PG8_STB(PG8_SB(0, 0), b2); PG8_STB(PG8_SB(0, 1), b2 + hstep); PG8_STAGE2(PG8_SA(0, 0), a2, o2[0][0], o2[0][1]); \
            PG8_WAIT_V(8); PG8_WAIT_L(0); PG8_BAR; PG8_MMA(1, 0, At, B0, Z); PG8_MMA(1, 1, At, B1, Z); PG8_BAR; PG8_SCHED; \
            PG8_LDB(B0, 1, 0); PG8_LDB(B1, 1, 1); PG8_SCHED; PG8_LDA(At, 1, 0); PG8_STAGE2(PG8_SA(0, 1), a2, o2[1][0], o2[1][1]); \
            PG8_WAIT_V(8); PG8_WAIT_L(0); PG8_BAR; PG8_MMA(0, 0, At, B0, 0); PG8_MMA(0, 1, At, B1, 0); PG8_BAR; PG8_SCHED; \
            PG8_LDA(At, 1, 1); PG8_STB(PG8_SB(1, 0), b3); PG8_STB(PG8_SB(1, 1), b3 + hstep); PG8_STAGE2(PG8_SA(1, 0), a3, o2[0][0], o2[0][1]); \
            PG8_WAIT_V(8); PG8_WAIT_L(0); PG8_BAR; PG8_MMA(1, 0, At, B0, 0); PG8_MMA(1, 1, At, B1, 0); PG8_BAR; PG8_SCHED; \
        } while (0)
        if constexpr (Sched::FP8) { int t = 0; PG8_TRIP(1); for (t = 2; t < ntc; t += 2) PG8_TRIP(0); }
        else { for (int t = 0; t < ntc; t += 2) PG8_TRIP(0); }
#undef PG8_TRIP
        if (wr == 0) PG8_BAR;
        E(acc, cur, wr, wc, fr, fq, lds + AUX_LDS_OFF + (ui % 3) * AUX_BUF);
#ifdef EPI_TWICE
        if constexpr (Epi::IDEMPOTENT) { asm volatile("" ::: "memory"); E(acc, cur, wr, wc, fr, fq, lds + AUX_LDS_OFF + (ui % 3) * AUX_BUF); }
#endif
        if (!has_next) break;
        PG8_ZERO_ACC;
        cur = nxt; cA = nA; cB = nB; ++ui;
        if constexpr (G) {
#pragma unroll
            for (int h = 0; h < 2; ++h)
#pragma unroll
                for (int i = 0; i < 2; ++i) aoC[h][i] = aoN[h][i];
        }
        if (wr == 1) PG8_BAR;
    }
    PG8_WAIT_V(0);
    PG8_BAR;
#undef PG8_ZERO_ACC
#undef PG8_SA
#undef PG8_SB
#undef PG8_STAGE2
#undef PG8_STB
#undef PG8_LDA
#undef PG8_LDB
#undef PG8_MMA
#undef PG8_WAIT_V
#undef PG8_WAIT_L
#undef PG8_BAR
#undef PG8_SCHED
}
}
using pg8::Unit;
typedef f32x4 AccT[2][2][4][2];

__device__ __forceinline__ float rstd_from_aux(const LAS unsigned char* aux, int r) {
    const f32x4 a = *((const LAS f32x4*)aux + r); return __builtin_amdgcn_rsqf(((a[0] + a[1]) + (a[2] + a[3])) * (1.0f / D) + EPS);
}
__device__ __forceinline__ float rstd_from_ssp(const float* ssp, int row) {
    const f32x4* p = (const f32x4*)(ssp + (size_t)row * 16); const f32x4 a = p[0], b = p[1], c = p[2], d = p[3];
    const float s = ((a[0] + a[1]) + (a[2] + a[3])) + ((b[0] + b[1]) + (b[2] + b[3])) + ((c[0] + c[1]) + (c[2] + c[3])) + ((d[0] + d[1]) + (d[2] + d[3]));
    return __builtin_amdgcn_rsqf(s * (1.0f / D) + EPS);
}

template <int AUXN, int NN> struct SchedDenseT {
    static constexpr bool GATHER = false, VARK = false, FP8 = false; static constexpr int SCALE_W = 127, SCALE_X = 127, AUX_OPS = AUXN;
    int nM, G, c; const char* A; const char* B; size_t tstep; const float* ssp4;
    __device__ __forceinline__ const float* aux_ptr(const Unit& u, int w) const { return ssp4 + (size_t)u.pm * 1024 + w * 256; }
    __device__ __forceinline__ bool next(int i, Unit& u) const { u.aux = 0; u.kc = -1; u.slab = 0; return pg8::static_order<NN>(nM, G, c, i, u.pm, u.pn); }
    __device__ __forceinline__ const char* a_ptr(const Unit& u) const { return A + (size_t)u.pm * tstep; }
    __device__ __forceinline__ const char* b_ptr(const Unit& u) const { return B + (size_t)u.pn * tstep; }
};

struct MoeTab { const LAS int* ts; const LAS int* cnt; const LAS int* tile; int nM; };
__device__ __forceinline__ int moe_expert_of(const MoeTab& T, int j) { int e = 0;
#pragma unroll
    for (int x = 1; x < 8; ++x) e += (j >= T.ts[x]) ? 1 : 0;
    return e; }

constexpr int MOE_SPLIT = 7, MOE_KC = DFE / MOE_SPLIT;
struct SchedMoeUp {
    static constexpr bool GATHER = true, VARK = false, FP8 = true; static constexpr int SCALE_W = 127 - WEGU_SH, SCALE_X = 127, AUX_OPS = 1, NN = 2 * DFE / 256;
    MoeTab T0, T1; int G, c; const char* A; const char* B; const int* ltok; const float* lrs;
    __device__ __forceinline__ bool next(int i, Unit& u) const {
        const int U0 = T0.nM * NN, U1 = T1.nM * NN; u.kc = -1; u.slab = 0;
        const int v = i * G + c; if (v >= U0 + U1) return false;
        const int k = v >= U0 ? 1 : 0;
        pg8::order_map<NN>(k ? T1.nM : T0.nM, v - (k ? U0 : 0), u.pm, u.pn);
        u.aux = (k << 30) | (k ? T1.tile : T0.tile)[u.pm]; return true; }
    __device__ __forceinline__ const char* a_ptr(const Unit&) const { return A; }
    __device__ __forceinline__ const char* b_ptr(const Unit& u) const { return B + ((size_t)((u.aux >> 16) & 7) * 2 * DFE + (size_t)u.pn * 256) * D; }
    __device__ __forceinline__ const int* list_ptr(const Unit& u) const { return ltok + (size_t)((u.aux >> 30) * 8 + ((u.aux >> 16) & 7)) * LCAP + (u.aux & 0xffff) * 256; }
    __device__ __forceinline__ const float* aux_ptr(const Unit& u, int) const { return lrs + (size_t)((u.aux >> 30) * 8 + ((u.aux >> 16) & 7)) * LCAP + (u.aux & 0xffff) * 256; }
    __device__ __forceinline__ int list_cnt(const Unit& u) const { const MoeTab& T = (u.aux >> 30) ? T1 : T0; const int r = T.cnt[(u.aux >> 16) & 7] - (u.aux & 0xffff) * 256; return r < 256 ? r : 256; }
};
struct SchedMoeDown {
    static constexpr bool GATHER = false, VARK = true, FP8 = true; static constexpr int SCALE_W = 127 - WED_SH, SCALE_X = 127 - ACT_SH, AUX_OPS = 2, NN = D / 256;
    MoeTab T; int G, c, k; const char* A; const char* B; const int* ltok; const float* lgate; int full, lf;
    __device__ __forceinline__ void init() { const int U = T.nM * NN; full = (U / G) * G; lf = U - full; }
    __device__ __forceinline__ bool next(int i, Unit& u) const {
        u.kc = -1; u.slab = 0;
        const int v = i * G + c; int L;
        if (v >= full + lf * MOE_SPLIT) return false;
        if (v < full) L = v; else { const int lo = v - full; L = full + lo / MOE_SPLIT; u.kc = lo % MOE_SPLIT; u.slab = lo; }
        pg8::order_map<NN>(T.nM, L, u.pm, u.pn);
        u.aux = T.tile[u.pm]; return true; }
    __device__ __forceinline__ const float* aux_ptr(const Unit& u, int w) const { const size_t lo = (size_t)(k * 8 + (u.aux >> 16)) * LCAP + (u.aux & 0xffff) * 256; return w ? lgate + lo : (const float*)(ltok + lo); }
    __device__ __forceinline__ int nt_of(const Unit& u) const { return u.kc >= 0 ? MOE_KC / 128 : DFE / 128; }
    __device__ __forceinline__ const char* a_ptr(const Unit& u) const { return A + (size_t)u.pm * 256 * DFE + (u.kc > 0 ? (size_t)u.kc * MOE_KC : 0); }
    __device__ __forceinline__ const char* b_ptr(const Unit& u) const { return B + ((size_t)(u.aux >> 16) * D + (size_t)u.pn * 256) * DFE + (u.kc > 0 ? (size_t)u.kc * MOE_KC : 0); }
};

struct EpiInProj {
    static constexpr bool IDEMPOTENT = true;
    bf16_t* Z; const float* ssp; const LAS float* gt;
    __device__ __forceinline__ void operator()(const AccT& acc, const Unit& u, int wr, int wc, int fr, int fq, const LAS unsigned char* aux) const {
        asm volatile("" : "+v"(fr), "+v"(fq));
        const int T = u.pn;
        int mode = 0; const LAS float* g = gt;
        if (T < 2) { mode = 1; g = gt; } else if (T == 2) { if (wc < 2) { mode = 1; g = gt + 64; } } else if (T == 3) { mode = 2; g = gt + 128; } else if (T == 4) { mode = 2; g = gt + 192; }
        f32x4 gv[2][2];
#pragma unroll
        for (int bj = 0; bj < 2; ++bj)
#pragma unroll
            for (int n = 0; n < 2; ++n) gv[bj][n] = mode == 0 ? (f32x4){1.f, 1.f, 1.f, 1.f} : *(const LAS f32x4*)(g + (mode == 1 ? 32 * bj : 0) + 8 * fq + 4 * n);
        const int row0 = u.pm * 256 + wr * 64 + fr;
#pragma unroll
        for (int ai = 0; ai < 2; ++ai)
#pragma unroll
            for (int m = 0; m < 4; ++m) {
                const int row = row0 + ai * 128 + m * 16; const float rs = rstd_from_aux(aux, wr * 64 + fr + ai * 128 + m * 16);
                f32x4 v[2][2]; float s0 = 0.f, s1 = 0.f;
#pragma unroll
                for (int n = 0; n < 2; ++n) { v[0][n] = acc[ai][0][m][n] * rs; v[1][n] = acc[ai][1][m][n] * rs;
                    s0 += (v[0][n][0] * v[0][n][0] + v[0][n][1] * v[0][n][1]) + (v[0][n][2] * v[0][n][2] + v[0][n][3] * v[0][n][3]);
                    s1 += (v[1][n][0] * v[1][n][0] + v[1][n][1] * v[1][n][1]) + (v[1][n][2] * v[1][n][2] + v[1][n][3] * v[1][n][3]); }
                float r0 = 1.f, r1 = 1.f;
                if (mode != 0) {
                    s0 = xor32_add(xor16_add(s0)); s1 = xor32_add(xor16_add(s1));
                    if (mode == 1) { r0 = r1 = __builtin_amdgcn_rsqf((s0 + s1) * (1.0f / 64.0f) + EPS); }
                    else { r0 = __builtin_amdgcn_rsqf(s0 * (1.0f / 32.0f) + EPS); r1 = __builtin_amdgcn_rsqf(s1 * (1.0f / 32.0f) + EPS); }
                }
                const int b = row >> 11, t = row & 2047;
                bf16_t* zp = Z + ((size_t)(b * LP + 128 + t)) * DIN + T * 256 + wc * 64 + 8 * fq;
#pragma unroll
                for (int bj = 0; bj < 2; ++bj) { const float rr = bj ? r1 : r0; const f32x4 a = v[bj][0] * gv[bj][0] * rr, c = v[bj][1] * gv[bj][1] * rr;
                    u32x4 w; w.x = cvt_pk_bf16(a[0], a[1]); w.y = cvt_pk_bf16(a[2], a[3]); w.z = cvt_pk_bf16(c[0], c[1]); w.w = cvt_pk_bf16(c[2], c[3]);
                    *(u32x4*)(zp + 32 * bj) = w; }
            }
    }
};

template <int MODE> struct EpiRes {
    static constexpr bool IDEMPOTENT = (MODE == 0);
    const float* res; bf16_t* hb; float* ssp; unsigned char* hb8; LAS float* rowsum;
    __device__ __forceinline__ void operator()(const AccT& acc, const Unit& u, int wr, int wc, int fr, int fq, const LAS unsigned char* aux) const {
        asm volatile("" : "+v"(fr), "+v"(fq));
        const int row0 = u.pm * 256 + wr * 64 + fr, col0 = u.pn * 256 + wc * 32 + 8 * fq;
#pragma unroll
        for (int ai = 0; ai < 2; ++ai) {
            u32x4 hv[4][2];
            if constexpr (MODE != 0) {
#pragma unroll
                for (int m = 0; m < 4; ++m)
#pragma unroll
                    for (int bj = 0; bj < 2; ++bj) hv[m][bj] = *(const u32x4*)(hb + (size_t)(row0 + ai * 128 + m * 16) * D + col0 + bj * 128);
                asm volatile("" ::: "memory");
            }
#pragma unroll
            for (int m = 0; m < 4; ++m) {
                const int row = row0 + ai * 128 + m * 16; const size_t off = (size_t)row * D + col0; float ss = 0.f;
#pragma unroll
                for (int bj = 0; bj < 2; ++bj) {
                    f32x4 a, c;
                    if constexpr (MODE == 0) { a = *(const f32x4*)(res + off + bj * 128); c = *(const f32x4*)(res + off + bj * 128 + 4); }
                    else { const u32x4 h = hv[m][bj]; a = (f32x4){bf16_lo(h.x), bf16_hi(h.x), bf16_lo(h.y), bf16_hi(h.y)}; c = (f32x4){bf16_lo(h.z), bf16_hi(h.z), bf16_lo(h.w), bf16_hi(h.w)}; }
                    a += acc[ai][bj][m][0]; c += acc[ai][bj][m][1];
                    u32x4 w; w.x = cvt_pk_bf16(a[0], a[1]); w.y = cvt_pk_bf16(a[2], a[3]); w.z = cvt_pk_bf16(c[0], c[1]); w.w = cvt_pk_bf16(c[2], c[3]);
                    *(u32x4*)(hb + off + bj * 128) = w;
                    if constexpr (MODE == 2) { u32x2 w8; w8.x = pack4_fp8(a[0], a[1], a[2], a[3]); w8.y = pack4_fp8(c[0], c[1], c[2], c[3]); *(u32x2*)(hb8 + off + bj * 128) = w8; }
                    ss += ((a[0] * a[0] + a[1] * a[1]) + (a[2] * a[2] + a[3] * a[3])) + ((c[0] * c[0] + c[1] * c[1]) + (c[2] * c[2] + c[3] * c[3])); }
                ss = xor32_add(xor16_add(ss));
                if (fq == 0) rowsum[(row - u.pm * 256) * 4 + wc] = ss;
            }
            asm volatile("" ::: "memory");
        }
        asm volatile("s_waitcnt lgkmcnt(0)" ::: "memory"); __builtin_amdgcn_s_barrier(); asm volatile("" ::: "memory");
        if (threadIdx.x < 256) { const f32x4 q = *((const LAS f32x4*)rowsum + threadIdx.x); ssp[(size_t)(u.pm * 256 + threadIdx.x) * 4 + u.pn] = (q[0] + q[1]) + (q[2] + q[3]); }
        asm volatile("s_waitcnt lgkmcnt(0)" ::: "memory"); __builtin_amdgcn_s_barrier(); asm volatile("" ::: "memory");
    }
};

__device__ __forceinline__ f32x4 swiglu4(f32x4 g, f32x4 u, float nrs, float irs2) {
    const f32x4 t = g * nrs; f32x4 e; e[0] = __builtin_amdgcn_exp2f(t[0]); e[1] = __builtin_amdgcn_exp2f(t[1]); e[2] = __builtin_amdgcn_exp2f(t[2]); e[3] = __builtin_amdgcn_exp2f(t[3]);
    const f32x4 d = e * irs2 + irs2; f32x4 r; r[0] = __builtin_amdgcn_rcpf(d[0]); r[1] = __builtin_amdgcn_rcpf(d[1]); r[2] = __builtin_amdgcn_rcpf(d[2]); r[3] = __builtin_amdgcn_rcpf(d[3]);
    return (g * u) * r;
}
__device__ __forceinline__ float silu_mul(float g, float u) { return g * __builtin_amdgcn_rcpf(1.0f + __builtin_amdgcn_exp2f(-g * LOG2E)) * u; }

struct EpiSwiglu {
    static constexpr bool IDEMPOTENT = true;
    bf16_t* act; const float* ssp;
    __device__ __forceinline__ void operator()(const AccT& acc, const Unit& u, int wr, int wc, int fr, int fq, const LAS unsigned char* aux) const {
        asm volatile("" : "+v"(fr), "+v"(fq));
        const int row0 = u.pm * 256 + wr * 64 + fr, col0 = u.pn * 128 + wc * 32 + 8 * fq;
#pragma unroll
        for (int ai = 0; ai < 2; ++ai)
#pragma unroll
            for (int m = 0; m < 4; ++m) {
                const int row = row0 + ai * 128 + m * 16; const float rs = rstd_from_aux(aux, wr * 64 + fr + ai * 128 + m * 16);
                const float nrs = -rs * LOG2E, irs2 = __builtin_amdgcn_rcpf(rs * rs);
                const f32x4 a0 = swiglu4(acc[ai][0][m][0], acc[ai][1][m][0], nrs, irs2), a1 = swiglu4(acc[ai][0][m][1], acc[ai][1][m][1], nrs, irs2);
                u32x4 w; w.x = cvt_pk_bf16(a0[0], a0[1]); w.y = cvt_pk_bf16(a0[2], a0[3]); w.z = cvt_pk_bf16(a1[0], a1[1]); w.w = cvt_pk_bf16(a1[2], a1[3]);
                __builtin_nontemporal_store(w, (u32x4*)(act + (size_t)row * DFF + col0));
            }
    }
};

struct EpiSwigluMoe {
    static constexpr bool IDEMPOTENT = true;
    unsigned char* act; const float* lrs; MoeTab T0, T1;
    __device__ __forceinline__ void operator()(const AccT& acc, const Unit& u, int wr, int wc, int fr, int fq, const LAS unsigned char* aux) const {
        asm volatile("" : "+v"(fr), "+v"(fq));
        const int k = u.aux >> 30, e = (u.aux >> 16) & 7, lt = u.aux & 0xffff; const MoeTab& T = k ? T1 : T0;
        const LAS float* lp = (const LAS float*)aux; const int cnt = T.cnt[e] - lt * 256;
        const int r0 = wr * 64 + fr, col0 = u.pn * 128 + wc * 32 + 8 * fq; constexpr float SC = (float)(1 << ACT_SH);
        unsigned char* abase = act; asm volatile("" : "+s"(abase));
        unsigned char* ab = abase + (size_t)k * ACTE_BYTES + (size_t)u.pm * 256 * DFE + col0;
#pragma unroll
        for (int ai = 0; ai < 2; ++ai)
#pragma unroll
            for (int m = 0; m < 4; ++m) {
                const int r = r0 + ai * 128 + m * 16; float rs = 0.f; if (r < cnt) rs = lp[r];
                const float nrs = -rs * LOG2E, irs2 = __builtin_amdgcn_rcpf(rs * rs * SC);
                const f32x4 a0 = swiglu4(acc[ai][0][m][0], acc[ai][1][m][0], nrs, irs2), a1 = swiglu4(acc[ai][0][m][1], acc[ai][1][m][1], nrs, irs2);
                u32x2 w; w.x = pack4_fp8(a0[0], a0[1], a0[2], a0[3]); w.y = pack4_fp8(a1[0], a1[1], a1[2], a1[3]);
                __builtin_nontemporal_store(w, (u32x2*)(ab + (size_t)r * DFE));
            }
    }
};

template <bool FIRST> struct EpiMoeDown {
    static constexpr bool IDEMPOTENT = false;
    float* out; bf16_t* hb; const int* ltok; const float* lgate; MoeTab T; int k; float* part;
    __device__ __forceinline__ void operator()(const AccT& acc, const Unit& u, int wr, int wc, int fr, int fq, const LAS unsigned char* aux) const {
        asm volatile("" : "+v"(fr), "+v"(fq));
        const int r0 = wr * 64 + fr;
        if (u.kc >= 0) {
            float* pbase = part; asm volatile("" : "+s"(pbase));
            float* pp = pbase + (size_t)u.slab * 65536 + wc * 32 + 8 * fq;
#pragma unroll
            for (int ai = 0; ai < 2; ++ai)
#pragma unroll
                for (int m = 0; m < 4; ++m) { float* rp = pp + (size_t)(r0 + ai * 128 + m * 16) * 256;
#pragma unroll
                    for (int bj = 0; bj < 2; ++bj) { *(f32x4*)(rp + bj * 128) = acc[ai][bj][m][0]; *(f32x4*)(rp + bj * 128 + 4) = acc[ai][bj][m][1]; } }
            return;
        }
        const int e = u.aux >> 16, lt = u.aux & 0xffff; const size_t lo = (size_t)(k * 8 + e) * LCAP + lt * 256; const int cnt = T.cnt[e] - lt * 256;
        const int col0 = u.pn * 256 + wc * 32 + 8 * fq;
#pragma unroll
        for (int ai = 0; ai < 2; ++ai) {
            int tk[4]; float gg[4]; u32x4 hv[4][2];
#pragma unroll
            for (int m = 0; m < 4; ++m) { const int r = r0 + ai * 128 + m * 16; const bool ok = r < cnt; tk[m] = ok ? ((const LAS int*)aux)[r] : 0; gg[m] = ok ? ((const LAS float*)aux)[256 + r] : 0.f; }
#pragma unroll
            for (int m = 0; m < 4; ++m)
#pragma unroll
                for (int bj = 0; bj < 2; ++bj) hv[m][bj] = *(const u32x4*)(hb + (size_t)tk[m] * D + col0 + bj * 128);
            asm volatile("" ::: "memory");
#pragma unroll
            for (int m = 0; m < 4; ++m) {
                const int r = r0 + ai * 128 + m * 16;
                if (r < cnt) { const int tok = tk[m]; const float g = gg[m]; float* op = out + (size_t)tok * D + col0; bf16_t* hp = hb + (size_t)tok * D + col0;
#pragma unroll
                    for (int bj = 0; bj < 2; ++bj) { const u32x4 h = hv[m][bj];
                        const f32x4 a = (f32x4){bf16_lo(h.x), bf16_hi(h.x), bf16_lo(h.y), bf16_hi(h.y)} + acc[ai][bj][m][0] * g, c = (f32x4){bf16_lo(h.z), bf16_hi(h.z), bf16_lo(h.w), bf16_hi(h.w)} + acc[ai][bj][m][1] * g;
                        if constexpr (FIRST) { u32x4 w; w.x = cvt_pk_bf16(a[0], a[1]); w.y = cvt_pk_bf16(a[2], a[3]); w.z = cvt_pk_bf16(c[0], c[1]); w.w = cvt_pk_bf16(c[2], c[3]); *(u32x4*)(hp + bj * 128) = w; }
                        else { *(f32x4*)(op + bj * 128) = a; *(f32x4*)(op + bj * 128 + 4) = c; } } }
            }
            asm volatile("" ::: "memory");
        }
    }
};

template <bool FIRST> __device__ __forceinline__ void moe_reduce(const MoeTab& T, int k, int G, float* out, bf16_t* hb, const int* ltok, const float* lgate, const float* part, int gw, int NGW, int lane) {
    const int nM = T.nM, U = nM * 4, full = (U / G) * G, lf = U - full, total = lf * 256;
    for (int base = gw; base < total; base += 4 * NGW) {
        int tok[4], pnv[4], jv[4], rv[4]; float g[4]; bool ok[4];
#pragma unroll
        for (int i = 0; i < 4; ++i) { const int w = base + i * NGW; ok[i] = w < total; const int ww = ok[i] ? w : base; jv[i] = ww >> 8; rv[i] = ww & 255; int pm; pg8::order_map<4>(nM, full + jv[i], pm, pnv[i]);
            const int tw = T.tile[pm], e = tw >> 16, lt = tw & 0xffff, cnt = T.cnt[e] - lt * 256; ok[i] = ok[i] && rv[i] < cnt;
            const size_t lo = (size_t)(k * 8 + e) * LCAP + lt * 256 + (ok[i] ? rv[i] : 0); tok[i] = ok[i] ? ltok[lo] : 0; g[i] = ok[i] ? lgate[lo] : 0.f; }
        f32x4 s[4]; u32x2 h[4];
#pragma unroll
        for (int i = 0; i < 4; ++i) { s[i] = (f32x4){0.f, 0.f, 0.f, 0.f};
#pragma unroll
            for (int c = 0; c < MOE_SPLIT; ++c) s[i] += *((const f32x4*)(part + (size_t)(jv[i] * MOE_SPLIT + c) * 65536 + (size_t)rv[i] * 256) + lane);
            h[i] = *((const u32x2*)(hb + (size_t)tok[i] * D + pnv[i] * 256) + lane); }
        asm volatile("" ::: "memory");
#pragma unroll
        for (int i = 0; i < 4; ++i) if (ok[i]) {
            const f32x4 v = (f32x4){bf16_lo(h[i].x), bf16_hi(h[i].x), bf16_lo(h[i].y), bf16_hi(h[i].y)} + s[i] * g[i];
            if constexpr (FIRST) { u32x2 w; w.x = cvt_pk_bf16(v[0], v[1]); w.y = cvt_pk_bf16(v[2], v[3]); *((u32x2*)(hb + (size_t)tok[i] * D + pnv[i] * 256) + lane) = w; }
            else *((f32x4*)(out + (size_t)tok[i] * D + pnv[i] * 256) + lane) = v; }
    }
}
__device__ __forceinline__ bool skinny16(LAS unsigned char* lds, const bf16_t* A, const bf16_t* Bt, int K, const int (&rowbase)[4], f32x4 (&acc)[4]) {
    const int tid = threadIdx.x, wid = __builtin_amdgcn_readfirstlane(tid >> 6), lane = tid & 63, fr = lane & 15, kq = lane >> 4;
    const int kw = K / 8, k0 = wid * kw;
#pragma unroll
    for (int cb = 0; cb < 4; ++cb) acc[cb] = (f32x4){0.f, 0.f, 0.f, 0.f};
    const bf16_t* ap = A + (size_t)fr * K + k0 + 8 * kq;
    const bf16_t* bp[4];
#pragma unroll
    for (int cb = 0; cb < 4; ++cb) bp[cb] = Bt + (size_t)(rowbase[cb] + fr) * K + k0 + 8 * kq;
    for (int s0 = 0; s0 < kw; s0 += 128) {
        bf16x8 a[4], b[4][4];
#pragma unroll
        for (int i = 0; i < 4; ++i) { const int s = (s0 + 32 * i < kw) ? s0 + 32 * i : s0; a[i] = *(const bf16x8*)(ap + s);
#pragma unroll
            for (int cb = 0; cb < 4; ++cb) b[i][cb] = *(const bf16x8*)(bp[cb] + s); }
#pragma unroll
        for (int i = 0; i < 4; ++i) if (s0 + 32 * i < kw) {
#pragma unroll
            for (int cb = 0; cb < 4; ++cb) acc[cb] = __builtin_amdgcn_mfma_f32_16x16x32_bf16(b[i][cb], a[i], acc[cb], 0, 0, 0); }
    }
    LAS f32x4* scr = (LAS f32x4*)lds;
#pragma unroll
    for (int cb = 0; cb < 4; ++cb) scr[(wid * 4 + cb) * 64 + lane] = acc[cb];
    __syncthreads();
    if (wid == 0) {
#pragma unroll
        for (int cb = 0; cb < 4; ++cb) { f32x4 s = scr[cb * 64 + lane];
#pragma unroll
            for (int w = 1; w < 8; ++w) s += scr[(w * 4 + cb) * 64 + lane];
            acc[cb] = s; }
    }
    __syncthreads();
    return wid == 0;
}

__device__ __forceinline__ void meta_inproj_unit(LAS unsigned char* lds, int j, const bf16_t* hmb, const bf16_t* win, const float* sspm, const float* gt, bf16_t* Z) {
    const int T = j >> 2, h = j & 3; const int rb[4] = {T * 256 + 32 * h, T * 256 + 32 * h + 16, T * 256 + 128 + 32 * h, T * 256 + 128 + 32 * h + 16};
    f32x4 acc[4];
    if (!skinny16(lds, hmb, win, D, rb, acc)) return;
    const int lane = threadIdx.x & 63, fr = lane & 15, fq = lane >> 4;
    const float rs = rstd_from_ssp(sspm, fr);
    int mode = 0; const float* g = gt;
    if (T < 2) { mode = 1; } else if (T == 2) { if (h < 2) { mode = 1; g = gt + 64; } } else if (T == 3) { mode = 2; g = gt + 128; } else if (T == 4) { mode = 2; g = gt + 192; }
    float s0 = 0.f, s1 = 0.f;
#pragma unroll
    for (int cb = 0; cb < 4; ++cb) { acc[cb] = acc[cb] * rs; const float q = (acc[cb][0] * acc[cb][0] + acc[cb][1] * acc[cb][1]) + (acc[cb][2] * acc[cb][2] + acc[cb][3] * acc[cb][3]); if (cb < 2) s0 += q; else s1 += q; }
    float r0 = 1.f, r1 = 1.f;
    if (mode != 0) {
        s0 = xor32_add(xor16_add(s0)); s1 = xor32_add(xor16_add(s1));
        if (mode == 1) { r0 = r1 = __builtin_amdgcn_rsqf((s0 + s1) * (1.0f / 64.0f) + EPS); }
        else { r0 = __builtin_amdgcn_rsqf(s0 * (1.0f / 32.0f) + EPS); r1 = __builtin_amdgcn_rsqf(s1 * (1.0f / 32.0f) + EPS); }
    }
#pragma unroll
    for (int cb = 0; cb < 4; ++cb) { const int c = cb >> 1, jc = 16 * (cb & 1) + 4 * fq;
        f32x4 v = acc[cb] * (c ? r1 : r0);
        if (mode != 0) v = v * *(const f32x4*)(g + (mode == 1 ? 32 * c : 0) + jc);
        u32x2 w; w.x = cvt_pk_bf16(v[0], v[1]); w.y = cvt_pk_bf16(v[2], v[3]);
        for (int b = 0; b < NBATCH; ++b) *(u32x2*)(Z + ((size_t)(b * LP + PADP + fr)) * DIN + T * 256 + 64 * h + 32 * c + jc) = w; }
}

__device__ __forceinline__ void meta_res_unit(LAS unsigned char* lds, int j, const bf16_t* A, const bf16_t* Bt, int K, float* hm, bf16_t* hmb, float* sspm) {
    const int rb[4] = {64 * j, 64 * j + 16, 64 * j + 32, 64 * j + 48};
    f32x4 acc[4];
    if (!skinny16(lds, A, Bt, K, rb, acc)) return;
    const int lane = threadIdx.x & 63, fr = lane & 15, fq = lane >> 4; float ss = 0.f;
#pragma unroll
    for (int cb = 0; cb < 4; ++cb) { const size_t off = (size_t)fr * D + 64 * j + 16 * cb + 4 * fq; const f32x4 v = *(const f32x4*)(hm + off) + acc[cb];
        *(f32x4*)(hm + off) = v; u32x2 w; w.x = cvt_pk_bf16(v[0], v[1]); w.y = cvt_pk_bf16(v[2], v[3]); *(u32x2*)(hmb + off) = w;
        ss += (v[0] * v[0] + v[1] * v[1]) + (v[2] * v[2] + v[3] * v[3]); }
    ss = xor32_add(xor16_add(ss));
    if (fq == 0) sspm[fr * 16 + j] = ss;
}

__device__ __forceinline__ void meta_ffnup_unit(LAS unsigned char* lds, int j, const bf16_t* hmb, const bf16_t* wgu, const float* sspm, bf16_t* actm) {
    const int T = j >> 2, h = j & 3; const int rb[4] = {T * 256 + 32 * h, T * 256 + 32 * h + 16, T * 256 + 128 + 32 * h, T * 256 + 128 + 32 * h + 16};
    f32x4 acc[4];
    if (!skinny16(lds, hmb, wgu, D, rb, acc)) return;
    const int lane = threadIdx.x & 63, fr = lane & 15, fq = lane >> 4;
    const float rs = rstd_from_ssp(sspm, fr);
#pragma unroll
    for (int cb = 0; cb < 2; ++cb) { const f32x4 g = acc[cb] * rs, u = acc[cb + 2] * rs;
        u32x2 w; w.x = cvt_pk_bf16(silu_mul(g[0], u[0]), silu_mul(g[1], u[1])); w.y = cvt_pk_bf16(silu_mul(g[2], u[2]), silu_mul(g[3], u[3]));
        *(u32x2*)(actm + (size_t)fr * DFF + 32 * j + 16 * cb + 4 * fq) = w; }
}
__device__ __forceinline__ int crow(int r, int hi) { return (r & 3) + 8 * (r >> 2) + 4 * hi; }
typedef short v4i16_t __attribute__((ext_vector_type(4)));
__device__ __forceinline__ s16x4 vtr(const LAS unsigned char* p) { return __builtin_bit_cast(s16x4, __builtin_amdgcn_ds_read_tr16_b64_v4i16((LAS v4i16_t*)p)); }

__device__ __forceinline__ bf16_t* mix_row(bf16_t* mix, bf16_t* mixm, int b, int pp) {
    if (pp >= 128) return mix + ((size_t)b * SEQ + (pp - 128)) * D;
    if (pp >= PADP && b == 0) return mixm + (size_t)(pp - PADP) * D;
    return nullptr;
}

__device__ __forceinline__ void softmax_step(f32x16& s0, f32x16& s1, float& m_run, float& l_run, f32x16 (&o)[2], LAS float* wsf, int r32, int hi) {
    float mx = s0[0];
#pragma unroll
    for (int r = 1; r < 16; ++r) mx = fmaxf(mx, s0[r]);
#pragma unroll
    for (int r = 0; r < 16; ++r) mx = fmaxf(mx, s1[r]);
    mx = xor32_max(mx);
    const float mn = fmaxf(m_run, mx), f = __builtin_amdgcn_exp2f(m_run - mn);
    m_run = mn;
    float sum = 0.f;
#pragma unroll
    for (int r = 0; r < 16; ++r) { s0[r] = __builtin_amdgcn_exp2f(s0[r] - mn); s1[r] = __builtin_amdgcn_exp2f(s1[r] - mn); sum += s0[r] + s1[r]; }
    l_run = l_run * f + sum;
    if (hi == 0) wsf[r32] = f;
    LDS_WAIT();
#pragma unroll
    for (int r = 0; r < 16; ++r) { const float fo = wsf[crow(r, hi)]; o[0][r] *= fo; o[1][r] *= fo; }
    LDS_WAIT();
}
__device__ __forceinline__ float max3(float a, float b, float c) { float r; asm("v_max3_f32 %0, %1, %2, %3" : "=v"(r) : "v"(a), "v"(b), "v"(c)); return r; }
__device__ __forceinline__ bf16x8 ones_frag() { u32x4 w; asm volatile("v_mov_b32 %0, 0x3f803f80\n\tv_mov_b32 %1, 0x3f803f80\n\tv_mov_b32 %2, 0x3f803f80\n\tv_mov_b32 %3, 0x3f803f80" : "=v"(w.x), "=v"(w.y), "=v"(w.z), "=v"(w.w)); return __builtin_bit_cast(bf16x8, w); }
__device__ __forceinline__ void rowsum_step(f32x16& l, const bf16x8 (&pa)[4], const bf16x8& ones) {
#pragma unroll
    for (int s = 0; s < 4; ++s) l = __builtin_amdgcn_mfma_f32_32x32x16_bf16(pa[s], ones, l, 0, 0, 0);
}
__device__ __forceinline__ void pack_p(const f32x16& s0, const f32x16& s1, bf16x8 (&pa)[4]) {
#pragma unroll
    for (int s = 0; s < 4; ++s) { const f32x16& p = (s < 2) ? s0 : s1; const int b = 8 * (s & 1);
        u32x4 w; w.x = cvt_pk_bf16(p[b], p[b + 1]); w.y = cvt_pk_bf16(p[b + 2], p[b + 3]); w.z = cvt_pk_bf16(p[b + 4], p[b + 5]); w.w = cvt_pk_bf16(p[b + 6], p[b + 7]);
        pa[s] = __builtin_bit_cast(bf16x8, w); }
}
__device__ __forceinline__ void pv_step(f32x16 (&o)[2], const bf16x8 (&pa)[4], const LAS unsigned char* vbase, int half_stride, int lane) {
    const int hi = lane >> 5; const LAS unsigned char* vp = vbase + (4 * hi + ((lane & 15) >> 2)) * 64 + ((lane >> 4) & 1) * 32 + (lane & 3) * 8;
#pragma unroll
    for (int d0 = 0; d0 < 2; ++d0)
#pragma unroll
        for (int s = 0; s < 4; ++s) { const s16x4 lo = vtr(vp + d0 * half_stride + s * 1024), hh = vtr(vp + d0 * half_stride + s * 1024 + 512);
            const bf16x8 vf = (bf16x8){lo[0], lo[1], lo[2], lo[3], hh[0], hh[1], hh[2], hh[3]};
            o[d0] = __builtin_amdgcn_mfma_f32_32x32x16_bf16(pa[s], vf, o[d0], 0, 0, 0); }
}

__device__ __forceinline__ void v_frags_asm(bf16x8 (&vf)[2][4], const LAS unsigned char* vbase, int lane) {
    const int hi = lane >> 5; const unsigned vp = (unsigned)(size_t)(vbase + (4 * hi + ((lane & 15) >> 2)) * 64 + ((lane >> 4) & 1) * 32 + (lane & 3) * 8);
    u32x2 r[16];
    asm volatile(
        "ds_read_b64_tr_b16 %0, %16\n\tds_read_b64_tr_b16 %1, %16 offset:512\n\tds_read_b64_tr_b16 %2, %16 offset:1024\n\tds_read_b64_tr_b16 %3, %16 offset:1536\n\t"
        "ds_read_b64_tr_b16 %4, %16 offset:2048\n\tds_read_b64_tr_b16 %5, %16 offset:2560\n\tds_read_b64_tr_b16 %6, %16 offset:3072\n\tds_read_b64_tr_b16 %7, %16 offset:3584\n\t"
        "ds_read_b64_tr_b16 %8, %16 offset:4096\n\tds_read_b64_tr_b16 %9, %16 offset:4608\n\tds_read_b64_tr_b16 %10, %16 offset:5120\n\tds_read_b64_tr_b16 %11, %16 offset:5632\n\t"
        "ds_read_b64_tr_b16 %12, %16 offset:6144\n\tds_read_b64_tr_b16 %13, %16 offset:6656\n\tds_read_b64_tr_b16 %14, %16 offset:7168\n\tds_read_b64_tr_b16 %15, %16 offset:7680\n\t"
        "s_waitcnt lgkmcnt(0)"
        : "=&v"(r[0]), "=&v"(r[1]), "=&v"(r[2]), "=&v"(r[3]), "=&v"(r[4]), "=&v"(r[5]), "=&v"(r[6]), "=&v"(r[7]), "=&v"(r[8]), "=&v"(r[9]), "=&v"(r[10]), "=&v"(r[11]), "=&v"(r[12]), "=&v"(r[13]), "=&v"(r[14]), "=&v"(r[15])
        : "v"(vp) : "memory");
#pragma unroll
    for (int d0 = 0; d0 < 2; ++d0)
#pragma unroll
        for (int s = 0; s < 4; ++s) { const u32x2 lo = r[d0 * 8 + s * 2], hh = r[d0 * 8 + s * 2 + 1]; const u32x4 w = (u32x4){lo.x, lo.y, hh.x, hh.y}; vf[d0][s] = __builtin_bit_cast(bf16x8, w); }
}
__device__ __forceinline__ void v_frags(bf16x8 (&vf)[2][4], const LAS unsigned char* vbase, int half_stride, int lane) {
    const int hi = lane >> 5; const LAS unsigned char* vp = vbase + (4 * hi + ((lane & 15) >> 2)) * 64 + ((lane >> 4) & 1) * 32 + (lane & 3) * 8;
#pragma unroll
    for (int d0 = 0; d0 < 2; ++d0)
#pragma unroll
        for (int s = 0; s < 4; ++s) { const s16x4 lo = vtr(vp + d0 * half_stride + s * 1024), hh = vtr(vp + d0 * half_stride + s * 1024 + 512);
            vf[d0][s] = (bf16x8){lo[0], lo[1], lo[2], lo[3], hh[0], hh[1], hh[2], hh[3]}; }
}
__device__ __forceinline__ void pv_from(f32x16 (&o)[2], const bf16x8 (&pa)[4], const bf16x8 (&vf)[2][4]) {
#pragma unroll
    for (int d0 = 0; d0 < 2; ++d0)
#pragma unroll
        for (int s = 0; s < 4; ++s) o[d0] = __builtin_amdgcn_mfma_f32_32x32x16_bf16(pa[s], vf[d0][s], o[d0], 0, 0, 0);
}

constexpr int AL_V = 0, AL_K = 2 * 256 * 64, AL_LUT = AL_K + 256 * 144, AL_EXT = AL_LUT + 4 * 128 * 4, AL_WS = AL_EXT + 4 * 256 * 4, AL_ST = AL_WS + 8 * 256, AL_END = AL_ST + 8 * 4096;
__device__ __forceinline__ void attnA_unit(LAS unsigned char* lds, int b, int kvh, int ib, const bf16_t* Z, bf16_t* mix, bf16_t* mixm, const float* lutA, const float* sinks) {
    const int tid = threadIdx.x, lane = tid & 63, wid = __builtin_amdgcn_readfirstlane(tid >> 6), r32 = lane & 31, hi = lane >> 5;
    const int kp0 = 128 * (ib - 1);
    const bf16_t* Zb = Z + (size_t)b * LP * DIN;
#pragma unroll
    for (int it = 0; it < 4; ++it) { const int idx = tid + 512 * it, row = idx >> 3, ch = idx & 7, kpp = kp0 + row;
        u32x4 kv = (u32x4){0u, 0u, 0u, 0u}, vv = kv;
        if (kpp >= 0) { const bf16_t* src = Zb + (size_t)kpp * DIN + 64 * kvh + 8 * ch; kv = *(const u32x4*)(src + ZKA); vv = *(const u32x4*)(src + ZVA); }
        *(LAS u32x4*)(lds + AL_K + row * 144 + ch * 16) = kv;
        *(LAS u32x4*)(lds + AL_V + (ch >> 2) * (256 * 64) + row * 64 + (ch & 3) * 16) = vv; }
    ((LAS float*)(lds + AL_LUT))[tid] = lutA[(4 * kvh + (tid >> 7)) * 128 + (tid & 127)];
    const bool fast = ib >= 2;
    if (fast) {
#pragma unroll
        for (int it = 0; it < 2; ++it) { const int idx = tid + 512 * it, hh = idx >> 8, n = (idx & 255) - 64;
            ((LAS float*)(lds + AL_EXT))[idx] = ((unsigned)n < 128u) ? lutA[(4 * kvh + hh) * 128 + n] - sinks[4 * kvh + hh] * LOG2E : NEGF; }
    }
    __syncthreads();
    const int hl = wid >> 1, hq = 4 * kvh + hl;
    LAS float* wsf = (LAS float*)(lds + AL_WS) + wid * 64;
    const LAS float* lut = (const LAS float*)(lds + AL_LUT) + hl * 128;
    const LAS float* ext = (const LAS float*)(lds + AL_EXT) + hl * 256 + (133 + r32 - 4 * hi);
    const float sink2 = sinks[hq] * LOG2E;
    bf16x8 qnext[4];
#pragma unroll
    for (int ks = 0; ks < 4; ++ks) qnext[ks] = *(const bf16x8*)(Zb + (size_t)(128 * ib + 64 * (wid & 1) + r32) * DIN + ZQA + 64 * hq + 16 * ks + 8 * hi);
#pragma unroll 1
    for (int sub = 0; sub < 2; ++sub) {
        const int qs = 128 * ib + 64 * (wid & 1) + 32 * sub, qpp = qs + r32;
        bf16x8 qr[4];
#pragma unroll
        for (int ks = 0; ks < 4; ++ks) qr[ks] = qnext[ks];
        if (sub == 0) {
#pragma unroll
            for (int ks = 0; ks < 4; ++ks) qnext[ks] = *(const bf16x8*)(Zb + (size_t)(qpp + 32) * DIN + ZQA + 64 * hq + 16 * ks + 8 * hi);
        }
        float m_run = NEGF, l_run = 0.f; f32x16 o[2]; o[0] = (f32x16){}; o[1] = (f32x16){};
        if (fast) {
            float m_off = 0.f;
#pragma unroll 1
            for (int jt = 0; jt < 3; ++jt) {
                const int kt = (wid & 1) + jt;
                const LAS float* ep = ext + (32 * sub - 64 * jt);
                f32x16 s0, s1;
#pragma unroll
                for (int r = 0; r < 16; ++r) { const int cr = (r & 3) + 8 * (r >> 2); s0[r] = ep[59 - cr]; s1[r] = ep[27 - cr]; }
                const LAS unsigned char* kb = lds + AL_K + (64 * kt + r32) * 144 + 16 * hi;
                bf16x8 kf0[4], kf1[4];
#pragma unroll
                for (int ks = 0; ks < 4; ++ks) { kf0[ks] = *(const LAS bf16x8*)(kb + ks * 32); kf1[ks] = *(const LAS bf16x8*)(kb + 32 * 144 + ks * 32); }
#pragma unroll
                for (int ks = 0; ks < 4; ++ks) { s0 = __builtin_amdgcn_mfma_f32_32x32x16_bf16(kf0[ks], qr[ks], s0, 0, 0, 0); s1 = __builtin_amdgcn_mfma_f32_32x32x16_bf16(kf1[ks], qr[ks], s1, 0, 0, 0); }
                bf16x8 vfa[2][4]; v_frags(vfa, lds + AL_V + (64 * kt) * 64, 256 * 64, lane);
                float mx = fmaxf(s0[0], s1[0]);
#pragma unroll
                for (int r = 1; r < 16; ++r) mx = fmaxf(mx, fmaxf(s0[r], s1[r]));
                mx = xor32_max(mx);
                if (__any(mx > m_off + 8.0f)) {
                    const float no = fmaxf(m_off, mx), f = __builtin_amdgcn_exp2f(m_off - no); m_off = no; l_run *= f;
                    if (hi == 0) wsf[r32] = f;
                    LDS_WAIT();
#pragma unroll
                    for (int r = 0; r < 16; ++r) { const float fo = wsf[crow(r, hi)]; o[0][r] *= fo; o[1][r] *= fo; }
                    LDS_WAIT();
                }
                if (__any(m_off != 0.f)) {
#pragma unroll
                    for (int r = 0; r < 16; ++r) { s0[r] -= m_off; s1[r] -= m_off; }
                }
                float sum = 0.f;
#pragma unroll
                for (int r = 0; r < 16; ++r) { s0[r] = __builtin_amdgcn_exp2f(s0[r]); s1[r] = __builtin_amdgcn_exp2f(s1[r]); sum += s0[r] + s1[r]; }
                l_run += sum;
                bf16x8 pa[4]; pack_p(s0, s1, pa);
                pv_from(o, pa, vfa);
            }
            m_run = sink2 + m_off;
        } else
#pragma unroll 1
        for (int jt = 0; jt < 3; ++jt) {
            const int kt = (wid & 1) + jt, kpp0 = kp0 + 64 * kt;
            f32x16 s0 = (f32x16){}, s1 = (f32x16){};
            const LAS unsigned char* kb = lds + AL_K + (64 * kt + r32) * 144 + 16 * hi;
#pragma unroll
            for (int ks = 0; ks < 4; ++ks) { const bf16x8 k0 = *(const LAS bf16x8*)(kb + ks * 32), k1 = *(const LAS bf16x8*)(kb + 32 * 144 + ks * 32);
                s0 = __builtin_amdgcn_mfma_f32_32x32x16_bf16(k0, qr[ks], s0, 0, 0, 0); s1 = __builtin_amdgcn_mfma_f32_32x32x16_bf16(k1, qr[ks], s1, 0, 0, 0); }
#pragma unroll
            for (int r = 0; r < 16; ++r) { const int kpp = kpp0 + crow(r, hi), n0 = qpp - kpp, n1 = n0 - 32;
                const bool v0 = ((unsigned)n0 < 128u) && (kpp >= PADP), v1 = ((unsigned)n1 < 128u) && (kpp + 32 >= PADP);
                s0[r] = v0 ? s0[r] + lut[n0 & 127] : NEGF; s1[r] = v1 ? s1[r] + lut[n1 & 127] : NEGF; }
            softmax_step(s0, s1, m_run, l_run, o, wsf, r32, hi);
            bf16x8 pa[4]; pack_p(s0, s1, pa);
            pv_step(o, pa, lds + AL_V + (64 * kt) * 64, 256 * 64, lane);
        }
        float lt = xor32_add(l_run); lt += __builtin_amdgcn_exp2f(sink2 - m_run);
        if (hi == 0) wsf[r32] = __builtin_amdgcn_rcpf(lt);
        LDS_WAIT();
#ifdef A_DIRECT_STORE
#pragma unroll
        for (int r = 0; r < 16; ++r) { const int q = crow(r, hi); const float inv = wsf[q]; bf16_t* orow = mix_row(mix, mixm, b, qs + q);
            if (orow) { orow[64 * hq + r32] = (bf16_t)(cvt_pk_bf16(o[0][r] * inv, 0.f) & 0xffffu); orow[64 * hq + 32 + r32] = (bf16_t)(cvt_pk_bf16(o[1][r] * inv, 0.f) & 0xffffu); } }
        LDS_WAIT();
#else
        LAS bf16_t* stg = (LAS bf16_t*)(lds + AL_ST) + wid * 2048;
#pragma unroll
        for (int r = 0; r < 16; ++r) { const int q = crow(r, hi); const float inv = wsf[q];
            stg[q * 64 + r32] = (bf16_t)(cvt_pk_bf16(o[0][r] * inv, 0.f) & 0xffffu); stg[q * 64 + 32 + r32] = (bf16_t)(cvt_pk_bf16(o[1][r] * inv, 0.f) & 0xffffu); }
        LDS_WAIT();
#pragma unroll
        for (int i = 0; i < 4; ++i) { const int row = i * 8 + (lane >> 3), ch = lane & 7; const u32x4 v = *(const LAS u32x4*)(stg + row * 64 + ch * 8);
            bf16_t* orow = mix_row(mix, mixm, b, qs + row); if (orow) *(u32x4*)(orow + 64 * hq + 8 * ch) = v; }
        LDS_WAIT();
#endif
    }
    __syncthreads();
}

constexpr int B2_RING = 0, B2_BT = 3 * 16384, B2_LUT = B2_BT + 7 * 4096, B2_WS = B2_LUT + 512, B2_X = B2_WS + 8 * 256, BL_END = B2_X + 4 * 32 * 68 * 4;
__device__ __forceinline__ void attnB_unit(LAS unsigned char* lds, int b, int h, int ib, const bf16_t* Z, bf16_t* mix, bf16_t* mixm, const float* lutB, const float* bt, bool chk, float lam, float one_m_lam_init, const float* gout) {
    const int tid = threadIdx.x, lane = tid & 63, wid = __builtin_amdgcn_readfirstlane(tid >> 6), r32 = lane & 31, hi = lane >> 5;
    const bf16_t* Zb = Z + (size_t)b * LP * DIN;
    const int KT_END = 2 * (ib + 1);
    const bf16x8 ones = ones_frag();
    const int c = wid >> 2, wq = wid & 3, qs = 128 * ib + 32 * wq, qpp = qs + r32;
#pragma unroll
    for (int i = 0; i < 4; ++i) { const int pc = wid + 8 * i; if (pc < 28) __builtin_amdgcn_global_load_lds((const unsigned*)(bt + h * 7168 + pc * 256 + lane * 4), (LAS unsigned*)(lds + B2_BT + pc * 1024), 16, 0, 0); }
    const bf16_t* ksrc = Zb + (size_t)lane * DIN + ZKB + 64 * h + 8 * wid;
    const bf16_t* vsrc = Zb + (size_t)(16 * (wid & 3) + (lane >> 2)) * DIN + ZVB + 64 * h + 32 * (wid >> 2) + 8 * (lane & 3);
#define B_DMA(t, slot) do { __builtin_amdgcn_global_load_lds((const unsigned*)(ksrc + (size_t)(64 * (t)) * DIN), (LAS unsigned*)(lds + B2_RING + (slot) * 16384 + wid * 1024), 16, 0, 0); \
                            __builtin_amdgcn_global_load_lds((const unsigned*)(vsrc + (size_t)(64 * (t)) * DIN), (LAS unsigned*)(lds + B2_RING + (slot) * 16384 + 8192 + wid * 1024), 16, 0, 0); } while (0)
    B_DMA(1, 0);
    if (2 < KT_END) B_DMA(2, 1);
    bf16x8 qr[2];
#pragma unroll
    for (int ks = 0; ks < 2; ++ks) qr[ks] = *(const bf16x8*)(Zb + (size_t)qpp * DIN + ZQB + 64 * h + 32 * c + 16 * ks + 8 * hi);
    const float* lg = lutB + h * 128;
    const float cfar = lg[127];
    if (tid < 128) ((LAS float*)(lds + B2_LUT))[tid] = lg[tid];
    LAS float* wsf = (LAS float*)(lds + B2_WS) + wid * 64;
    const LAS float* lut = (const LAS float*)(lds + B2_LUT);
    float mref = 0.f; f32x16 o[2], lsum; o[0] = (f32x16){}; o[1] = (f32x16){}; lsum = (f32x16){};
    f32x16 negm;
#pragma unroll
    for (int r = 0; r < 16; ++r) negm[r] = cfar;
    int slot = 0;
    for (int t = 1; t < KT_END; ++t) {
        if (t + 1 < KT_END) asm volatile("s_waitcnt vmcnt(2)" ::: "memory"); else asm volatile("s_waitcnt vmcnt(0)" ::: "memory");
        asm volatile("s_waitcnt lgkmcnt(0)" ::: "memory");
        __builtin_amdgcn_s_barrier();
        asm volatile("" ::: "memory");
        const int kpp0 = 64 * t;
        const bool late_dma = (t == 1) && (kpp0 <= qs + 31);
        if (!late_dma && t + 2 < KT_END) { const int s2 = slot == 0 ? 2 : slot - 1; B_DMA(t + 2, s2); }
        if (kpp0 <= qs + 31) {
            const LAS unsigned char* kb = lds + B2_RING + slot * 16384 + (4 * c + hi) * 1024 + r32 * 16;
            const bf16x8 k00 = *(const LAS bf16x8*)(kb), k01 = *(const LAS bf16x8*)(kb + 2048), k10 = *(const LAS bf16x8*)(kb + 512), k11 = *(const LAS bf16x8*)(kb + 2048 + 512);
            f32x16 s0, s1; bool resc = false; float delta = 0.f;
            bf16x8 vfr[2][4];
            if (t == 1) {
                s0 = (f32x16){}; s1 = (f32x16){};
                s0 = __builtin_amdgcn_mfma_f32_32x32x16_bf16(k00, qr[0], s0, 0, 0, 0); s1 = __builtin_amdgcn_mfma_f32_32x32x16_bf16(k10, qr[0], s1, 0, 0, 0);
                s0 = __builtin_amdgcn_mfma_f32_32x32x16_bf16(k01, qr[1], s0, 0, 0, 0); s1 = __builtin_amdgcn_mfma_f32_32x32x16_bf16(k11, qr[1], s1, 0, 0, 0);
                v_frags_asm(vfr, lds + B2_RING + slot * 16384 + 8192, lane); asm volatile("" :: "v"(k00), "v"(k01), "v"(k10), "v"(k11));
                float mx = NEGF;
#pragma unroll
                for (int r = 0; r < 16; ++r) { const int kpp = kpp0 + crow(r, hi), n0 = qpp - kpp, n1 = n0 - 32;
                    const bool v0 = (n0 >= 0) && (kpp >= PADP), v1 = (n1 >= 0) && (kpp + 32 >= PADP);
                    s0[r] = v0 ? s0[r] + lut[n0 > 127 ? 127 : (n0 & 127)] : NEGF; s1[r] = v1 ? s1[r] + lut[n1 > 127 ? 127 : (n1 & 127)] : NEGF; mx = fmaxf(mx, fmaxf(s0[r], s1[r])); }
                asm volatile("" ::: "memory");
                if (t + 2 < KT_END) { const int s2 = slot == 0 ? 2 : slot - 1; B_DMA(t + 2, s2); }
                mx = xor32_max(mx);
                mref = mx;
#pragma unroll
                for (int r = 0; r < 16; ++r) { s0[r] -= mx; s1[r] -= mx; negm[r] = cfar - mx; }
            } else {
                const int d0 = qs - kpp0;
                if (d0 >= 192) {
                    s0 = __builtin_amdgcn_mfma_f32_32x32x16_bf16(k00, qr[0], negm, 0, 0, 0); s1 = __builtin_amdgcn_mfma_f32_32x32x16_bf16(k10, qr[0], negm, 0, 0, 0);
                    s0 = __builtin_amdgcn_mfma_f32_32x32x16_bf16(k01, qr[1], s0, 0, 0, 0); s1 = __builtin_amdgcn_mfma_f32_32x32x16_bf16(k11, qr[1], s1, 0, 0, 0);
                    v_frags_asm(vfr, lds + B2_RING + slot * 16384 + 8192, lane); asm volatile("" :: "v"(k00), "v"(k01), "v"(k10), "v"(k11));
                } else {
                    const int j0 = (d0 >> 5) + 1, j1 = j0 - 1;
                    const LAS f32x4* t0 = (const LAS f32x4*)(lds + B2_BT) + j0 * 256 + lane; const LAS f32x4* t1 = (const LAS f32x4*)(lds + B2_BT) + j1 * 256 + lane;
#pragma unroll
                    for (int g = 0; g < 4; ++g) { const f32x4 a = t0[g * 64], bq = t1[g * 64]; s0[4 * g] = a[0]; s0[4 * g + 1] = a[1]; s0[4 * g + 2] = a[2]; s0[4 * g + 3] = a[3]; s1[4 * g] = bq[0]; s1[4 * g + 1] = bq[1]; s1[4 * g + 2] = bq[2]; s1[4 * g + 3] = bq[3]; }
                    s0 = __builtin_amdgcn_mfma_f32_32x32x16_bf16(k00, qr[0], s0, 0, 0, 0); s1 = __builtin_amdgcn_mfma_f32_32x32x16_bf16(k10, qr[0], s1, 0, 0, 0);
                    s0 = __builtin_amdgcn_mfma_f32_32x32x16_bf16(k01, qr[1], s0, 0, 0, 0); s1 = __builtin_amdgcn_mfma_f32_32x32x16_bf16(k11, qr[1], s1, 0, 0, 0);
                    v_frags_asm(vfr, lds + B2_RING + slot * 16384 + 8192, lane); asm volatile("" :: "v"(k00), "v"(k01), "v"(k10), "v"(k11));
#pragma unroll
                    for (int r = 0; r < 16; ++r) { s0[r] -= mref; s1[r] -= mref; }
                }
                if (chk) {
                    float mx = fmaxf(s0[0], s1[0]);
#pragma unroll
                    for (int r = 1; r < 16; ++r) mx = max3(mx, s0[r], s1[r]);
                    mx = xor32_max(mx);
                    if (__any(mx > 8.0f)) {
                        delta = fmaxf(mx, 0.f); mref += delta; resc = true;
#pragma unroll
                        for (int r = 0; r < 16; ++r) { s0[r] -= delta; s1[r] -= delta; negm[r] = cfar - mref; }
                    }
                }
            }
#pragma unroll
            for (int r = 0; r < 16; ++r) { s0[r] = __builtin_amdgcn_exp2f(s0[r]); s1[r] = __builtin_amdgcn_exp2f(s1[r]); }
            if (resc) {
                const float f = __builtin_amdgcn_exp2f(-delta);
                if (hi == 0) wsf[r32] = f;
                LDS_WAIT();
#pragma unroll
                for (int r = 0; r < 16; ++r) { const float fo = wsf[crow(r, hi)]; o[0][r] *= fo; o[1][r] *= fo; lsum[r] *= fo; }
                LDS_WAIT();
            }
            bf16x8 pa[4]; pack_p(s0, s1, pa);
            rowsum_step(lsum, pa, ones);
            pv_from(o, pa, vfr);
        }
        slot = slot == 2 ? 0 : slot + 1;
    }
#undef B_DMA
    LAS float* X = (LAS float*)(lds + B2_X) + wq * (32 * 68);
#pragma unroll
    for (int r = 0; r < 16; ++r) { const float inv = __builtin_amdgcn_rcpf(lsum[r]); o[0][r] *= inv; o[1][r] *= inv; }
    if (c == 1) {
#pragma unroll
        for (int r = 0; r < 16; ++r) { const int q = crow(r, hi); X[q * 68 + r32] = o[0][r]; X[q * 68 + 32 + r32] = o[1][r]; }
    }
    __syncthreads();
    if (c == 0) {
#pragma unroll
        for (int r = 0; r < 16; ++r) { const int q = crow(r, hi); X[q * 68 + r32] = o[0][r] - lam * X[q * 68 + r32]; X[q * 68 + 32 + r32] = o[1][r] - lam * X[q * 68 + 32 + r32]; }
        LDS_WAIT();
        const int q = lane >> 1, hf = lane & 1; f32x4 v[8]; float ss = 0.f;
#pragma unroll
        for (int i = 0; i < 8; ++i) { v[i] = *(const LAS f32x4*)(X + q * 68 + 32 * hf + 4 * i); ss += (v[i][0] * v[i][0] + v[i][1] * v[i][1]) + (v[i][2] * v[i][2] + v[i][3] * v[i][3]); }
        ss += __shfl_xor(ss, 1);
        const float rs = __builtin_amdgcn_rsqf(ss * (1.0f / 64.0f) + EPS) * one_m_lam_init;
        bf16_t* orow = mix_row(mix, mixm, b, qs + q);
#pragma unroll
        for (int i = 0; i < 4; ++i) { const f32x4 g0 = *(const f32x4*)(gout + 32 * hf + 8 * i), g1 = *(const f32x4*)(gout + 32 * hf + 8 * i + 4); const f32x4 a = v[2 * i] * g0 * rs, d = v[2 * i + 1] * g1 * rs;
            u32x4 w; w.x = cvt_pk_bf16(a[0], a[1]); w.y = cvt_pk_bf16(a[2], a[3]); w.z = cvt_pk_bf16(d[0], d[1]); w.w = cvt_pk_bf16(d[2], d[3]);
            if (orow) *(u32x4*)(orow + 512 + 64 * h + 32 * hf + 8 * i) = w; }
    }
    __syncthreads();
}

constexpr int CL_U = 0, CL_D = 80 * 528, CL_END = CL_D + 64 * 528;
__device__ __forceinline__ void pool_unit(LAS unsigned char* lds, int b, int jb, const bf16_t* Z, bf16_t* mix, bf16_t* mixm, const bf16_t* wpt, const float* pscale) {
    const int tid = threadIdx.x, lane = tid & 63, wid = __builtin_amdgcn_readfirstlane(tid >> 6), r32 = lane & 31, hi = lane >> 5;
    const bf16_t* Zb = Z + (size_t)b * LP * DIN;
    const int pp0 = 64 * jb;
    const int g = wid >> 1, rh = wid & 1;
    bf16x8 afr[4][2]; f32x4 scv[2][4];
#pragma unroll
    for (int ks = 0; ks < 4; ++ks)
#pragma unroll
        for (int dh = 0; dh < 2; ++dh) afr[ks][dh] = *(const bf16x8*)(wpt + ((size_t)g * 64 + 32 * dh + r32) * 64 + 16 * ks + 8 * hi);
#pragma unroll
    for (int dh = 0; dh < 2; ++dh)
#pragma unroll
        for (int rq = 0; rq < 4; ++rq) scv[dh][rq] = *(const f32x4*)(pscale + 64 * g + 32 * dh + 8 * rq + 4 * hi);
#pragma unroll
    for (int it = 0; it < 5; ++it) { const int idx = tid + 512 * it, row = idx >> 5, ch = idx & 31;
        *(LAS u32x4*)(lds + CL_U + row * 528 + ch * 16) = *(const u32x4*)(Zb + (size_t)(pp0 - 16 + row) * DIN + ZUC + 8 * ch); }
    __syncthreads();
    { const int t = tid >> 3, pos = pp0 + t - PADP;
#pragma unroll
      for (int cc = 0; cc < 4; ++cc) { const int ch = (tid & 7) * 4 + cc, g = ch >> 3, w = 2 << g; int cnt = pos + 1 < w ? pos + 1 : w; cnt = cnt < 1 ? 1 : cnt;
          float acc[8];
#pragma unroll
          for (int e = 0; e < 8; ++e) acc[e] = 0.f;
          u32x4 x0 = (u32x4){0u, 0u, 0u, 0u};
          for (int j = 0; j < cnt; ++j) { const u32x4 x = *(const LAS u32x4*)(lds + CL_U + (16 + t - j) * 528 + ch * 16); if (j == 0) x0 = x;
              acc[0] += bf16_lo(x.x); acc[1] += bf16_hi(x.x); acc[2] += bf16_lo(x.y); acc[3] += bf16_hi(x.y); acc[4] += bf16_lo(x.z); acc[5] += bf16_hi(x.z); acc[6] += bf16_lo(x.w); acc[7] += bf16_hi(x.w); }
          const float ic = 1.0f / (float)cnt;
          u32x4 d; d.x = cvt_pk_bf16(acc[0] * ic - bf16_lo(x0.x), acc[1] * ic - bf16_hi(x0.x)); d.y = cvt_pk_bf16(acc[2] * ic - bf16_lo(x0.y), acc[3] * ic - bf16_hi(x0.y));
          d.z = cvt_pk_bf16(acc[4] * ic - bf16_lo(x0.z), acc[5] * ic - bf16_hi(x0.z)); d.w = cvt_pk_bf16(acc[6] * ic - bf16_lo(x0.w), acc[7] * ic - bf16_hi(x0.w));
          *(LAS u32x4*)(lds + CL_D + t * 528 + ch * 16) = d; } }
    __syncthreads();
    f32x16 acc[2]; acc[0] = (f32x16){}; acc[1] = (f32x16){};
    bf16x8 bfr[4];
#pragma unroll
    for (int ks = 0; ks < 4; ++ks) bfr[ks] = *(const LAS bf16x8*)(lds + CL_D + (32 * rh + r32) * 528 + (64 * g + 16 * ks + 8 * hi) * 2);
#pragma unroll
    for (int ks = 0; ks < 4; ++ks) {
#pragma unroll
        for (int dh = 0; dh < 2; ++dh) acc[dh] = __builtin_amdgcn_mfma_f32_32x32x16_bf16(afr[ks][dh], bfr[ks], acc[dh], 0, 0, 0); }
    bf16_t* orow = mix_row(mix, mixm, b, pp0 + 32 * rh + r32);
    if (orow) {
#pragma unroll
        for (int dh = 0; dh < 2; ++dh)
#pragma unroll
            for (int rq = 0; rq < 4; ++rq) { const int dd = 32 * dh + 8 * rq + 4 * hi; const f32x4 sc = scv[dh][rq];
                u32x2 w; w.x = cvt_pk_bf16(acc[dh][4 * rq] * sc[0], acc[dh][4 * rq + 1] * sc[1]); w.y = cvt_pk_bf16(acc[dh][4 * rq + 2] * sc[2], acc[dh][4 * rq + 3] * sc[3]);
                *(u32x2*)(orow + 768 + 64 * g + dd) = w; }
    }
    __syncthreads();
}
__device__ __forceinline__ void cvt_item(const float* s0, const float* s1, int ld, bf16_t* dst, int K, const float* gk, LAS unsigned* scr, int lane) {
    const int c = lane & 15, q = lane >> 4;
    const float* src = ((c >> 3) ? s1 : s0) + 4 * (c & 7);
    f32x4 a[8], b[8];
#pragma unroll
    for (int jj = 0; jj < 8; ++jj) { const int k = 8 * jj + 2 * q; a[jj] = *(const f32x4*)(src + (size_t)k * ld); b[jj] = *(const f32x4*)(src + (size_t)(k + 1) * ld); }
#pragma unroll
    for (int jj = 0; jj < 8; ++jj) { const int k = 8 * jj + 2 * q; float g0 = 1.f, g1 = 1.f; if (gk) { g0 = gk[k]; g1 = gk[k + 1]; }
#pragma unroll
        for (int e = 0; e < 4; ++e) scr[(4 * c + e) * 33 + 4 * jj + q] = cvt_pk_bf16(a[jj][e] * g0, b[jj][e] * g1); }
    LDS_WAIT(); asm volatile("" ::: "memory");
#pragma unroll
    for (int p = 0; p < 8; ++p) { const int n = p * 8 + (lane >> 3), ch = lane & 7; const LAS unsigned* s = scr + n * 33 + 4 * ch;
        u32x4 o; o.x = s[0]; o.y = s[1]; o.z = s[2]; o.w = s[3];
        *(u32x4*)(dst + (size_t)n * K + 8 * ch) = o; }
    LDS_WAIT(); asm volatile("" ::: "memory");
}

__device__ __forceinline__ void cvt_item8(const float* s0, const float* s1, int ld, unsigned char* dst, int KB, const float* gk, float sc, LAS unsigned* scr, int lane) {
    const int c = lane & 15, q = lane >> 4;
    const float* src = ((c >> 3) ? s1 : s0) + 4 * (c & 7);
    f32x4 v[4][4];
#pragma unroll
    for (int jj = 0; jj < 4; ++jj)
#pragma unroll
        for (int i = 0; i < 4; ++i) v[jj][i] = *(const f32x4*)(src + (size_t)(16 * jj + 4 * q + i) * ld);
#pragma unroll
    for (int jj = 0; jj < 4; ++jj) { float g[4];
#pragma unroll
        for (int i = 0; i < 4; ++i) g[i] = (gk ? gk[16 * jj + 4 * q + i] : 1.0f) * sc;
#pragma unroll
        for (int e = 0; e < 4; ++e) scr[(4 * c + e) * 17 + 4 * jj + q] = pack4_fp8(v[jj][0][e] * g[0], v[jj][1][e] * g[1], v[jj][2][e] * g[2], v[jj][3][e] * g[3]); }
    LDS_WAIT(); asm volatile("" ::: "memory");
#pragma unroll
    for (int p = 0; p < 4; ++p) { const int n = p * 16 + (lane >> 2), ch = lane & 3; const LAS unsigned* s = scr + n * 17 + 4 * ch;
        u32x4 o; o.x = s[0]; o.y = s[1]; o.z = s[2]; o.w = s[3];
        *(u32x4*)(dst + (size_t)n * KB + 16 * ch) = o; }
    LDS_WAIT(); asm volatile("" ::: "memory");
}

struct ProArgs {
    const float *x, *meta, *relb, *g_mix, *w_in, *gain_a, *gain_b, *dlam, *w_pool, *w_out, *g_ffn, *wg, *wu, *wd, *w_router, *weg, *weu, *wed;
    unsigned char* ws;
};
constexpr int IT_WIN = 2 * 16 * 28, IT_WOUT = 2 * 16 * 16, IT_WGU = 16 * 88, IT_WD = 44 * 16, IT_WEGU = 8 * 16 * 112, IT_WED = 8 * 56 * 16;
constexpr int IT_TOTAL = IT_WIN + IT_WOUT + IT_WGU + IT_WD + IT_WEGU + IT_WED;
constexpr size_t MS_GT = MS_END;
constexpr size_t MS_LAM = MS_GT + 2 * 4 * 64 * 4;
constexpr size_t MS_BT = MS_LAM + 256;
constexpr size_t MS_BCHK = MS_BT + 4 * 7 * 4096;
constexpr size_t MS_WRB = MS_BCHK + 256;
static_assert(MS_WRB + 16 * 1024 * 2 <= 10 * MiB, "misc map");

__device__ __forceinline__ void convert_item(const ProArgs& P, int it, LAS unsigned* scr, int lane) {
    unsigned char* ws = P.ws;
    if (it < IT_WIN) { const int l = it / (16 * 28), r = it % (16 * 28), kb = r / 28, nb = r % 28, T = nb >> 2, blk = nb & 3, c = blk >> 1, hp = blk & 1;
        const float* W = P.w_in + (size_t)l * D * DIN + (size_t)(64 * kb) * DIN + 256 * T + 32 * c;
        cvt_item(W + 64 * (2 * hp), W + 64 * (2 * hp + 1), DIN, (bf16_t*)(ws + WS_WIN) + ((size_t)l * DIN + 64 * nb) * D + 64 * kb, D, P.g_mix + l * D + 64 * kb, scr, lane); return; }
    it -= IT_WIN;
    if (it < IT_WOUT) { const int l = it / 256, r = it % 256, kb = r / 16, nb = r % 16;
        const float* W = P.w_out + (size_t)l * D * D + (size_t)(64 * kb) * D + 64 * nb;
        cvt_item(W, W + 32, D, (bf16_t*)(ws + WS_WOUT) + ((size_t)l * D + 64 * nb) * D + 64 * kb, D, nullptr, scr, lane); return; }
    it -= IT_WOUT;
    if (it < IT_WGU) { const int kb = it / 88, nb = it % 88, T = nb >> 2, blk = nb & 3;
        const float* W = ((blk < 2) ? P.wg : P.wu) + (size_t)(64 * kb) * DFF + 128 * T + 64 * (blk & 1);
        cvt_item(W, W + 32, DFF, (bf16_t*)(ws + WS_WGU) + ((size_t)64 * nb) * D + 64 * kb, D, P.g_ffn + 64 * kb, scr, lane); return; }
    it -= IT_WGU;
    if (it < IT_WD) { const int kb = it / 16, nb = it % 16;
        const float* W = P.wd + (size_t)(64 * kb) * D + 64 * nb;
        cvt_item(W, W + 32, D, (bf16_t*)(ws + WS_WD) + ((size_t)64 * nb) * DFF + 64 * kb, DFF, nullptr, scr, lane); return; }
    it -= IT_WD;
    if (it < IT_WEGU) { const int e = it / (16 * 112), r = it % (16 * 112), kb = r / 112, nb = r % 112, T = nb >> 2, blk = nb & 3;
        const float* W = ((blk < 2) ? P.weg : P.weu) + (size_t)e * D * DFE + (size_t)(64 * kb) * DFE + 128 * T + 64 * (blk & 1);
        cvt_item8(W, W + 32, DFE, ws + WS_WEGU + ((size_t)e * 2 * DFE + 64 * nb) * D + 64 * kb, D, P.g_ffn + D + 64 * kb, (float)(1 << WEGU_SH), scr, lane); return; }
    it -= IT_WEGU;
    { const int e = it / (56 * 16), r = it % (56 * 16), kb = r / 16, nb = r % 16;
        const float* W = P.wed + (size_t)e * DFE * D + (size_t)(64 * kb) * D + 64 * nb;
        cvt_item8(W, W + 32, D, ws + WS_WED + ((size_t)e * D + 64 * nb) * DFE + 64 * kb, DFE, nullptr, (float)(1 << WED_SH), scr, lane); }
}

__device__ __forceinline__ void row_setup(const float* xrow, bf16_t* hb, float* ssp, float* fcopy, int lane, int nssp4) {
    const f32x4* xr = (const f32x4*)xrow + lane; f32x4 v[4]; float s = 0.f;
#pragma unroll
    for (int j = 0; j < 4; ++j) { v[j] = xr[64 * j]; s += (v[j][0] * v[j][0] + v[j][1] * v[j][1]) + (v[j][2] * v[j][2] + v[j][3] * v[j][3]); }
    s = wave_sum(s);
#pragma unroll
    for (int j = 0; j < 4; ++j) { u32x2 w; w.x = cvt_pk_bf16(v[j][0], v[j][1]); w.y = cvt_pk_bf16(v[j][2], v[j][3]); *((u32x2*)hb + lane + 64 * j) = w; if (fcopy) *((f32x4*)fcopy + lane + 64 * j) = v[j]; }
    if (lane < nssp4) *((f32x4*)ssp + lane) = (f32x4){lane == 0 ? s : 0.f, 0.f, 0.f, 0.f};
}

__device__ __forceinline__ int t5_bucket(int n) {
    if (n < 16) return n;
    const int v = 16 + (int)(__logf((float)n * (1.0f / 16.0f)) / 2.0794415416798357f * 16.0f);
    return v < 31 ? v : 31;
}

__device__ __forceinline__ void prologue(const ProArgs& P, LAS unsigned char* lds, int vcu, int G) {
    const int tid = threadIdx.x, lane = tid & 63, wave = __builtin_amdgcn_readfirstlane(tid >> 6);
    unsigned char* ws = P.ws; unsigned char* ms = ws + WS_MISC;
    const int gw = vcu * NWAVES + wave, NGW = G * NWAVES, gt_ = vcu * NTHREADS + tid, NGT = G * NTHREADS;
    for (int m = gw; m < M; m += NGW) row_setup(P.x + (size_t)m * D, (bf16_t*)(ws + WS_HB) + (size_t)m * D, (float*)(ms + MS_SSP) + (size_t)m * 4, nullptr, lane, 1);
    if (gw < NMETA) row_setup(P.meta + (size_t)gw * D, (bf16_t*)(ms + MS_HMB) + (size_t)gw * D, (float*)(ms + MS_SSPM) + gw * 16, (float*)(ms + MS_HM) + (size_t)gw * D, lane, 4);
    for (int i = gt_; i < 12 * 128; i += NGT) { const int h = i >> 7, n = i & 127; const float v = P.relb[t5_bucket(n) * 12 + h] * LOG2E;
        if (h < 8) ((float*)(ms + MS_LUTA))[h * 128 + n] = v; else ((float*)(ms + MS_LUTB))[(h - 8) * 128 + n] = v; }
    for (int i = gt_; i < 2 * 4 * 64; i += NGT) { const int l = i >> 8, t = (i >> 6) & 3, j = i & 63; float v = 0.f;
        if (t == 0) v = P.gain_a[(l * 2 + 0) * 64 + j] * 0.125f * LOG2E; else if (t == 1) v = P.gain_a[(l * 2 + 1) * 64 + j];
        else if (t == 2) { if (j < 32) v = P.gain_b[(l * 2 + 0) * 32 + j] * 0.17677669529663687f * LOG2E; } else { if (j < 32) v = P.gain_b[(l * 2 + 1) * 32 + j]; }
        ((float*)(ms + MS_GT))[i] = v; }
    if (gt_ < 2) { const int l = gt_; const float* dl = P.dlam + l * 128; float s1 = 0.f, s2 = 0.f;
        for (int j = 0; j < 32; ++j) { s1 += dl[j] * dl[32 + j]; s2 += dl[64 + j] * dl[96 + j]; }
        ((float*)(ms + MS_LAM))[l] = __expf(s1) - __expf(s2) + (0.8f - 0.6f * __expf(-0.3f * (float)l)); }
    for (int i = gt_; i < 2 * 4 * 64 * 64; i += NGT) { const int c = i & 63, dd = (i >> 6) & 63, lg = i >> 12;
        const float v = P.w_pool[((size_t)lg * 64 + c) * 64 + dd]; ((bf16_t*)(ms + MS_WPT))[i] = (bf16_t)(cvt_pk_bf16(v, 0.f) & 0xffffu); }
    for (int i = gt_; i < 1024 * 8; i += NGT) { const float wv = P.w_router[i] * P.g_ffn[D + (i >> 3)]; ((float*)(ms + MS_WR))[i] = wv;
        const int k = i >> 3, e = i & 7; const unsigned hi = cvt_pk_bf16(wv, 0.f) & 0xffffu; const unsigned lo = cvt_pk_bf16(wv - __uint_as_float(hi << 16), 0.f) & 0xffffu;
        ((bf16_t*)(ms + MS_WRB))[e * 1024 + k] = (bf16_t)hi; ((bf16_t*)(ms + MS_WRB))[(8 + e) * 1024 + k] = (bf16_t)lo; }
    if (gw < 8) { const int l = gw >> 2, h = gw & 3, j = lane & 31;
        float gq = fabsf(P.gain_b[(l * 2 + 0) * 32 + j]) * 0.17677669529663687f * LOG2E, gk = fabsf(P.gain_b[(l * 2 + 1) * 32 + j]);
        const float b0 = P.relb[t5_bucket(lane) * 12 + 8 + h] * LOG2E, b1 = P.relb[t5_bucket(lane + 64) * 12 + 8 + h] * LOG2E; float bmax = fmaxf(b0, b1), bmin = fminf(b0, b1);
#pragma unroll
        for (int o = 1; o < 64; o <<= 1) { gq = fmaxf(gq, __shfl_xor(gq, o)); gk = fmaxf(gk, __shfl_xor(gk, o)); bmax = fmaxf(bmax, __shfl_xor(bmax, o)); bmin = fminf(bmin, __shfl_xor(bmin, o)); }
        const float bound = 64.0f * 1.02f * gq * gk + (bmax - bmin);
        if (lane == 0) ((int*)(ms + MS_BCHK))[gw] = (bound < 96.0f) ? 0 : 1; }
    for (int i = gt_; i < 4 * 7 * 1024; i += NGT) { const int h = i / 7168, rem = i - h * 7168, j = rem >> 10, e = rem & 1023, ln = e >> 4, r = e & 15; const int n = 32 * (j - 1) + (ln & 31) - ((r & 3) + 8 * (r >> 2) + 4 * (ln >> 5));
        ((float*)(ms + MS_BT))[h * 7168 + j * 1024 + (r >> 2) * 256 + ln * 4 + (r & 3)] = n < 0 ? NEGF : P.relb[t5_bucket(n > 127 ? 127 : n) * 12 + 8 + h] * LOG2E; }
    { const int per = PADP * DIN * 2 / 16; for (int i = gt_; i < NBATCH * per; i += NGT) { const int b = i / per, r = i % per; *((u32x4*)(ws + WS_Z + (size_t)b * LP * DIN * 2) + r) = (u32x4){0u, 0u, 0u, 0u}; } }
    LAS unsigned* scr = (LAS unsigned*)lds + wave * (64 * 33);
    for (int it = gw; it < IT_TOTAL; it += NGW) convert_item(P, it, scr, lane);
}

__device__ __forceinline__ void router_phase(LAS unsigned char* lds, const bf16_t* hres, const bf16_t* wrb, const float* ssp4, float* lrs, int* ltok, float* lgate, unsigned* cnt, int vcu, int G) {
    const int tid = threadIdx.x, lane = tid & 63, wave = __builtin_amdgcn_readfirstlane(tid >> 6);
    LAS int* e0s = (LAS int*)lds; LAS int* e1s = e0s + 128; LAS float* g0s = (LAS float*)(e1s + 128); LAS float* g1s = g0s + 128;
    LAS unsigned* lcnt = (LAS unsigned*)(g1s + 128); LAS unsigned* lbase = lcnt + 16; LAS unsigned* rk0 = lbase + 16; LAS unsigned* rk1 = rk0 + 128; LAS float* rss = (LAS float*)(rk1 + 128);
    for (int chunk = vcu; chunk < M / 128; chunk += G) {
        if (tid < 16) lcnt[tid] = 0u;
        {
            const int tok0 = chunk * 128 + wave * 16;
            const bf16_t* hb = hres + (size_t)(tok0 + (lane & 15)) * D + 8 * (lane >> 4);
            const bf16_t* wb = wrb + (size_t)(lane & 15) * D + 8 * (lane >> 4);
            f32x4 acc = (f32x4){0.f, 0.f, 0.f, 0.f};
#pragma unroll 8
            for (int k0 = 0; k0 < D; k0 += 32) acc = __builtin_amdgcn_mfma_f32_16x16x32_bf16(*(const bf16x8*)(wb + k0), *(const bf16x8*)(hb + k0), acc, 0, 0, 0);
            float lg[8];
#pragma unroll
            for (int i = 0; i < 4; ++i) { const float s = xor32_add(acc[i]);
                const auto r = __builtin_amdgcn_permlane16_swap(__float_as_uint(s), __float_as_uint(s), false, false); lg[i] = __uint_as_float(r[0]); lg[4 + i] = __uint_as_float(r[1]); }
            if (lane < 16) {
                const f32x4 q4 = *(const f32x4*)(ssp4 + (size_t)(tok0 + lane) * 4);
                const float rs = __builtin_amdgcn_rsqf(((q4[0] + q4[1]) + (q4[2] + q4[3])) * (1.0f / D) + EPS);
                int b0 = 0; float v0 = lg[0] * rs;
#pragma unroll
                for (int e = 1; e < 8; ++e) { const float v = lg[e] * rs; if (v > v0) { v0 = v; b0 = e; } }
                int b1 = -1; float v1 = 0.f;
#pragma unroll
                for (int e = 0; e < 8; ++e) { const float v = lg[e] * rs; if (e != b0 && (b1 < 0 || v > v1)) { v1 = v; b1 = e; } }
                const float ex = __expf(v1 - v0), gg0 = 1.0f / (1.0f + ex), gg1 = ex * gg0;
                const int s = wave * 16 + lane; e0s[s] = b0; e1s[s] = b1; g0s[s] = gg0; g1s[s] = gg1; rss[s] = rs;
            }
        }
        __syncthreads();
        if (tid < 128) { rk0[tid] = __hip_atomic_fetch_add(&lcnt[e0s[tid]], 1u, __ATOMIC_RELAXED, __HIP_MEMORY_SCOPE_WORKGROUP); rk1[tid] = __hip_atomic_fetch_add(&lcnt[8 + e1s[tid]], 1u, __ATOMIC_RELAXED, __HIP_MEMORY_SCOPE_WORKGROUP); }
        __syncthreads();
        if (tid < 16) lbase[tid] = __hip_atomic_fetch_add(cnt + 64 * tid, lcnt[tid], __ATOMIC_RELAXED, __HIP_MEMORY_SCOPE_AGENT);
        __syncthreads();
        if (tid < 128) { const int tok = chunk * 128 + tid; const int ga = e0s[tid], gb = 8 + e1s[tid];
            const unsigned sa = lbase[ga] + rk0[tid], sb = lbase[gb] + rk1[tid];
            ltok[(size_t)ga * LCAP + sa] = tok; lgate[(size_t)ga * LCAP + sa] = g0s[tid]; lrs[(size_t)ga * LCAP + sa] = rss[tid]; ltok[(size_t)gb * LCAP + sb] = tok; lgate[(size_t)gb * LCAP + sb] = g1s[tid]; lrs[(size_t)gb * LCAP + sb] = rss[tid]; }
        __syncthreads();
    }
}

constexpr int MOE_TMAX = 144;
__device__ __forceinline__ void moe_tables_fill(const unsigned* cnt, volatile LAS unsigned* tab, volatile LAS unsigned* tmap) {
    const int lane = threadIdx.x & 63; int cl = 0;
    if (lane < 16) cl = (int)__hip_atomic_load(cnt + 64 * lane, __ATOMIC_RELAXED, __HIP_MEMORY_SCOPE_AGENT);
#pragma unroll
    for (int k = 0; k < 2; ++k) { int s = 0; int me = 0, mlt = 0; const int j = threadIdx.x;
#pragma unroll
        for (int e = 0; e < 8; ++e) { const int c = __builtin_amdgcn_readlane(cl, k * 8 + e);
            if (threadIdx.x == 0) { tab[32 * k + e] = (unsigned)s; tab[32 * k + 16 + e] = (unsigned)c; }
            const int nt = (c + 255) >> 8; if (j >= s && j < s + nt) { me = e; mlt = j - s; } s += nt; }
        if (threadIdx.x == 0) tab[32 * k + 8] = (unsigned)s;
        if (j < MOE_TMAX) tmap[MOE_TMAX * k + j] = (unsigned)((me << 16) | mlt); }
    __syncthreads();
}
__device__ __forceinline__ MoeTab moe_tab(volatile LAS unsigned* tab, volatile LAS unsigned* tmap, int k) { MoeTab T; T.ts = (const LAS int*)tab + 32 * k; T.cnt = (const LAS int*)tab + 32 * k + 16; T.tile = (const LAS int*)tmap + MOE_TMAX * k;
    T.nM = __builtin_amdgcn_readfirstlane(T.ts[8]); return T; }
#define XB_TMO      128
#define XB_XCNT(j)  (256  + 64 * (j))
#define XB_XSUB(j)  (1280 + 64 * (j))
#define XB_XGEN(j)  (2304 + 64 * (j))
#define XB_TOP      3328
#define XB_TOPGEN   3392
#define XCD_BAR_WORDS 3456
#define XB_SPIN_CAP (1u << 18)
__device__ __forceinline__ unsigned xb_ld(unsigned* p)              { return __hip_atomic_load(p, __ATOMIC_RELAXED, __HIP_MEMORY_SCOPE_AGENT); }
__device__ __forceinline__ unsigned xb_add(unsigned* p, unsigned v) { return __hip_atomic_fetch_add(p, v, __ATOMIC_RELAXED, __HIP_MEMORY_SCOPE_AGENT); }
__device__ __forceinline__ unsigned xb_xcc_id() { return (unsigned)__builtin_amdgcn_s_getreg((3 << 11) | 20) & 0xFu; }
#define XB_SPIN(cond, bar) do { unsigned _sp = 0; while (cond) { __builtin_amdgcn_s_sleep(1); \
    if ((++_sp & 255u) == 0u) { if (xb_ld(&(bar)[XB_TMO])) break; if (_sp > XB_SPIN_CAP) { atomicAdd(&(bar)[XB_TMO], 1u); break; } } } } while (0)
struct XcdBarrier { unsigned* bar; unsigned x; volatile LAS unsigned* st; };
__device__ __forceinline__ XcdBarrier xcd_barrier_post(unsigned* bar, volatile LAS unsigned* st) {
    XcdBarrier b; b.bar = bar; b.x = xb_xcc_id(); b.st = st;
    if (threadIdx.x == 0) (void)xb_add(&bar[XB_XCNT(b.x)], 1u);
    return b;
}
__device__ __forceinline__ void xcd_barrier_complete(unsigned* bar, unsigned x, unsigned& nloc, unsigned& nx) {
    const unsigned G = gridDim.x * gridDim.y * gridDim.z;
    unsigned sum, cnt, mine, sp = 0u;
    for (;;) {
        sum = 0u; cnt = 0u; mine = 0u;
#pragma unroll
        for (unsigned j = 0; j < 16; ++j) { const unsigned c = xb_ld(&bar[XB_XCNT(j)]); sum += c; cnt += (c > 0u) ? 1u : 0u; mine = (j == x) ? c : mine; }
        if (sum == G) break;
        __builtin_amdgcn_s_sleep(1);
        if ((++sp & 255u) == 0u) { if (xb_ld(&bar[XB_TMO])) break; if (sp > XB_SPIN_CAP) { atomicAdd(&bar[XB_TMO], 1u); break; } }
    }
    nloc = mine > 0u ? mine : 1u; nx = cnt > 0u ? cnt : 1u;
}
__device__ __forceinline__ void xcd_barrier(const XcdBarrier& b) {
    asm volatile("s_waitcnt vmcnt(0)" ::: "memory");
    __syncthreads();
    if (threadIdx.x == 0) {
        unsigned* bar = b.bar;
        __builtin_amdgcn_s_waitcnt(0);
        unsigned nloc = b.st[0], nx = b.st[1];
        if (nloc == 0u) { xcd_barrier_complete(bar, b.x, nloc, nx); b.st[0] = nloc; b.st[1] = nx; }
        const unsigned old = xb_add(&bar[XB_XSUB(b.x)], 1u);
        const unsigned gen = old / nloc;
        if (old + 1u == (gen + 1u) * nloc) {
            __builtin_amdgcn_fence(__ATOMIC_RELEASE, "agent");
            asm volatile("s_waitcnt vmcnt(0)" ::: "memory");
            const unsigned og = xb_add(&bar[XB_TOP], 1u);
            const unsigned tg = og / nx;
            if (og + 1u == (tg + 1u) * nx) xb_add(&bar[XB_TOPGEN], 1u);
            else XB_SPIN(xb_ld(&bar[XB_TOPGEN]) == tg, bar);
            __builtin_amdgcn_fence(__ATOMIC_ACQUIRE, "agent");
            xb_add(&bar[XB_XGEN(b.x)], 1u);
            asm volatile("s_waitcnt vmcnt(0)" ::: "memory");
        } else {
            XB_SPIN(xb_ld(&bar[XB_XGEN(b.x)]) == gen, bar);
            __builtin_amdgcn_fence(__ATOMIC_ACQUIRE, "agent");
            asm volatile("s_waitcnt vmcnt(0)" ::: "memory");
        }
    }
    __syncthreads();
}

constexpr int RING_BYTES = 131072, LDS_TOK = RING_BYTES, LDSCTL_OFF = RING_BYTES + 1024 + 3 * pg8::AUX_BUF, LDS_BYTES = 147456;
static_assert(LDSCTL_OFF + 1024 + 2 * MOE_TMAX * 4 <= LDS_BYTES, "LDS map");
static_assert(AL_END <= RING_BYTES && BL_END <= RING_BYTES && CL_END <= RING_BYTES && pg8::TOK_LDS_OFF == LDS_TOK, "LDS map");

#ifndef MK_PER_PHASE
#define MK_PER_PHASE 0
#endif
#ifndef PH_LIMIT
#define PH_LIMIT 15
#endif
constexpr int N_PHASES = PH_LIMIT;

struct Args { const float* in[21]; float* out; unsigned char* ws; int ph_lo, ph_hi; };

template <int L> __device__ __forceinline__ void mixer_phase(const Args& a, LAS unsigned char* lds, volatile LAS unsigned* MISC, gu32* ctl, int qrep) {
    unsigned char* ws = a.ws; unsigned char* ms = ws + WS_MISC;
    const bf16_t* Z = (const bf16_t*)(ws + WS_Z); bf16_t* mix = (bf16_t*)(ws + WS_MIX); bf16_t* mixm = (bf16_t*)(ms + MS_MIXM);
    const float* lutA = (const float*)(ms + MS_LUTA); const float* lutB = (const float*)(ms + MS_LUTB); const float* btiles = (const float*)(ms + MS_BT); const int* bchkp = (const int*)(ms + MS_BCHK) + L * 4; const int bchk4 = __builtin_amdgcn_readfirstlane((bchkp[0] != 0 ? 1 : 0) | (bchkp[1] != 0 ? 2 : 0) | (bchkp[2] != 0 ? 4 : 0) | (bchkp[3] != 0 ? 8 : 0));
    const float lam = ((const float*)(ms + MS_LAM))[L]; const float omli = 1.0f - (0.8f - 0.6f * __expf(-0.3f * (float)L));
    const float* sinks = a.in[6] + L * 8; const float* gout = a.in[9] + L * 64; const float* pscale = a.in[11] + L * 256;
    const bf16_t* wpt = (const bf16_t*)(ms + MS_WPT) + (size_t)L * 4 * 64 * 64;
    constexpr int NBU = 1024, NBM = (L == 0) ? 4 : 0, NAU = 512, NAM = (L == 0) ? 2 : 0, NCU = 512, NCM = (L == 0) ? 1 : 0;
#define QPOP(q) __hip_atomic_fetch_add(ctl + CW_QUEUE + 64 * (6 * L + (q) + 12 * qrep), 1u, __ATOMIC_RELAXED, __HIP_MEMORY_SCOPE_AGENT)
#define QPOP_ASYNC(q) __hip_atomic_fetch_add(ctl + CW_QUEUE + 64 * (6 * L + (q) + 12 * qrep) + qzero, 1u, __ATOMIC_RELAXED, __HIP_MEMORY_SCOPE_AGENT)
#define QUEUE_LOOP(q, END, BODY) { unsigned pf = 0u; unsigned qzero = 0u; asm volatile("" : "+v"(qzero)); if (threadIdx.x == 0) MISC[4] = QPOP(q); __syncthreads(); int u = (int)MISC[4]; __syncthreads(); \
        while (u < (END)) { if (threadIdx.x == 0) pf = QPOP_ASYNC(q); BODY \
            if (threadIdx.x == 0) MISC[4] = pf; __syncthreads(); u = (int)MISC[4]; __syncthreads(); } }
#ifndef MIXREP
#define MIXREP 0
#endif
#define LOOP_B(qq) QUEUE_LOOP(qq, NBU + NBM, \
        if (u < NBU) { const int ib = 16 - (u >> 6); const int r = u & 63; attnB_unit(lds, r >> 2, r & 3, ib, Z, mix, mixm, lutB, btiles, ((bchk4 >> (r & 3)) & 1) != 0, lam, omli, gout); } \
        else attnB_unit(lds, 0, u - NBU, 0, Z, mix, mixm, lutB, btiles, ((bchk4 >> (u - NBU)) & 1) != 0, lam, omli, gout); )
#define LOOP_A(qq) QUEUE_LOOP(qq, NAU + NAM, \
        if (u < NAU) { const int ib = 1 + (u & 15); const int r = u >> 4; attnA_unit(lds, r >> 1, r & 1, ib, Z, mix, mixm, lutA, sinks); } \
        else attnA_unit(lds, 0, u - NAU, 0, Z, mix, mixm, lutA, sinks); )
#define LOOP_C(qq) QUEUE_LOOP(qq, NCU + NCM, \
        if (u < NCU) pool_unit(lds, u >> 5, 2 + (u & 31), Z, mix, mixm, wpt, pscale); \
        else pool_unit(lds, 0, 1, Z, mix, mixm, wpt, pscale); )
    LOOP_B(0)
    if (MIXREP & 1) { LOOP_B(3) }
    LOOP_A(1)
    if (MIXREP & 2) { LOOP_A(4) }
    LOOP_C(2)
    if (MIXREP & 4) { LOOP_C(5) }
#undef LOOP_A
#undef LOOP_B
#undef LOOP_C
#undef QUEUE_LOOP
#undef QPOP
#undef QPOP_ASYNC
}

__global__ void __launch_bounds__(NTHREADS, 2) fwd_kernel(Args a) {
    extern __shared__ __attribute__((aligned(16))) unsigned char lds_raw[];
    LAS unsigned char* lds = (LAS unsigned char*)lds_raw;
    volatile LAS unsigned* MISC = (volatile LAS unsigned*)(lds + LDSCTL_OFF);
    const int tid = threadIdx.x;
    const int G = gridDim.x, bx = blockIdx.x, vcu = (G % 8 == 0) ? (bx % 8) * (G / 8) + bx / 8 : bx;
    unsigned char* ws = a.ws; unsigned char* ms = ws + WS_MISC;
    gu32* ctl = (gu32*)(ws + WS_CTL);
    for (int u = tid; u < 64; u += NTHREADS) MISC[u] = 0u;
    __syncthreads();
    XcdBarrier bar; bar.bar = (unsigned*)(ctl + CW_BAR); bar.x = 0; bar.st = nullptr;
    if (!MK_PER_PHASE) bar = xcd_barrier_post((unsigned*)(ctl + CW_BAR), MISC + 8);
    const int lo = a.ph_lo, hi = a.ph_hi;
#ifndef PH_MASK
#define PH_MASK 0xffffffffu
#endif
#define IN(k) (((PH_MASK >> (k)) & 1u) && lo <= (k) && (k) < hi)
#define SEAM(k) do { if (IN(k) && IN((k) + 1)) xcd_barrier(bar); } while (0)
#ifndef REP_MASK
#define REP_MASK 0u
#endif
#define REPS(k) (((REP_MASK >> (k)) & 1u) ? 2 : 1)
    bf16_t* HB = (bf16_t*)(ws + WS_HB); float* SSP = (float*)(ms + MS_SSP);
    bf16_t* Zb = (bf16_t*)(ws + WS_Z); bf16_t* MIX = (bf16_t*)(ws + WS_MIX);
    float* HM = (float*)(ms + MS_HM); bf16_t* HMB = (bf16_t*)(ms + MS_HMB); float* SSPM = (float*)(ms + MS_SSPM); bf16_t* MIXM = (bf16_t*)(ms + MS_MIXM); bf16_t* ACTM = (bf16_t*)(ms + MS_ACTM);
    const float* GT = (const float*)(ms + MS_GT);
    LAS float* ROWSUM = (LAS float*)(lds + pg8::AUX_LDS_OFF);
    const int mj0 = G - 1 - bx;

    if (IN(0)) _Pragma("unroll") for (int rep = 0; rep < REPS(0); ++rep) { if (rep) xcd_barrier(bar);
        ProArgs P; P.x = a.in[0]; P.meta = a.in[1]; P.relb = a.in[2]; P.g_mix = a.in[3]; P.w_in = a.in[4]; P.gain_a = a.in[5]; P.gain_b = a.in[7]; P.dlam = a.in[8]; P.w_pool = a.in[10];
        P.w_out = a.in[12]; P.g_ffn = a.in[13]; P.wg = a.in[14]; P.wu = a.in[15]; P.wd = a.in[16]; P.w_router = a.in[17]; P.weg = a.in[18]; P.weu = a.in[19]; P.wed = a.in[20]; P.ws = ws;
        prologue(P, lds, vcu, G);
    }
    SEAM(0);
    if (IN(1)) _Pragma("unroll") for (int rep = 0; rep < REPS(1); ++rep) { if (rep) xcd_barrier(bar);
        for (int j = mj0; j < 28; j += G) meta_inproj_unit(lds, j, HMB, (const bf16_t*)(ws + WS_WIN), SSPM, GT, Zb);
        SchedDenseT<4, DIN / 256> S{M / 256, G, bx, (const char*)HB, (const char*)(ws + WS_WIN), (size_t)256 * D * 2, SSP};
        LAS float* GL = (LAS float*)(lds + LDSCTL_OFF + 1024); if (tid < 256) GL[tid] = GT[tid]; __syncthreads();
        EpiInProj E{Zb, SSP, GL};
        pg8::gemm_phase(lds, 2 * D, S, E);
    }
    SEAM(1);
    if (IN(2)) { mixer_phase<0>(a, lds, MISC, ctl, 0); if (REPS(2) > 1) { xcd_barrier(bar); mixer_phase<0>(a, lds, MISC, ctl, 1); } }
    SEAM(2);
    if (IN(3)) _Pragma("unroll") for (int rep = 0; rep < REPS(3); ++rep) { if (rep) xcd_barrier(bar);
        for (int j = mj0; j < 16; j += G) meta_res_unit(lds, j, MIXM, (const bf16_t*)(ws + WS_WOUT), D, HM, HMB, SSPM);
        SchedDenseT<0, D / 256> S{M / 256, G, bx, (const char*)MIX, (const char*)(ws + WS_WOUT), (size_t)256 * D * 2, SSP};
        EpiRes<1> E{nullptr, HB, SSP, nullptr, ROWSUM};
        pg8::gemm_phase(lds, 2 * D, S, E);
    }
    SEAM(3);
    if (IN(4)) _Pragma("unroll") for (int rep = 0; rep < REPS(4); ++rep) { if (rep) xcd_barrier(bar);
        for (int j = mj0; j < 88; j += G) meta_ffnup_unit(lds, j, HMB, (const bf16_t*)(ws + WS_WGU), SSPM, ACTM);
        SchedDenseT<4, 2 * DFF / 256> S{M / 256, G, bx, (const char*)HB, (const char*)(ws + WS_WGU), (size_t)256 * D * 2, SSP};
        EpiSwiglu E{(bf16_t*)(ws + WS_ACT), SSP};
        pg8::gemm_phase(lds, 2 * D, S, E);
    }
    SEAM(4);
    if (IN(5)) {
        for (int j = mj0; j < 16; j += G) meta_res_unit(lds, j, ACTM, (const bf16_t*)(ws + WS_WD), DFF, HM, HMB, SSPM);
        SchedDenseT<0, D / 256> S{M / 256, G, bx, (const char*)(ws + WS_ACT), (const char*)(ws + WS_WD), (size_t)256 * DFF * 2, SSP};
        EpiRes<1> E{nullptr, HB, SSP, nullptr, ROWSUM};
        pg8::gemm_phase(lds, 2 * DFF, S, E);
    }
    SEAM(5);
    if (IN(6)) _Pragma("unroll") for (int rep = 0; rep < REPS(6); ++rep) { if (rep) xcd_barrier(bar);
        for (int j = mj0; j < 28; j += G) meta_inproj_unit(lds, j, HMB, (const bf16_t*)(ws + WS_WIN) + (size_t)DIN * D, SSPM, GT + 256, Zb);
        SchedDenseT<4, DIN / 256> S{M / 256, G, bx, (const char*)HB, (const char*)(ws + WS_WIN) + (size_t)DIN * D * 2, (size_t)256 * D * 2, SSP};
        LAS float* GL = (LAS float*)(lds + LDSCTL_OFF + 1024); if (tid < 256) GL[tid] = GT[256 + tid]; __syncthreads();
        EpiInProj E{Zb, SSP, GL};
        pg8::gemm_phase(lds, 2 * D, S, E);
    }
    SEAM(6);
    if (IN(7)) { mixer_phase<1>(a, lds, MISC, ctl, 0); if (REPS(7) > 1) { xcd_barrier(bar); mixer_phase<1>(a, lds, MISC, ctl, 1); } }
    SEAM(7);
    if (IN(8)) {
        SchedDenseT<0, D / 256> S{M / 256, G, bx, (const char*)MIX, (const char*)(ws + WS_WOUT) + (size_t)D * D * 2, (size_t)256 * D * 2, SSP};
        EpiRes<2> E{nullptr, HB, SSP, ws + WS_HB8, ROWSUM};
        pg8::gemm_phase(lds, 2 * D, S, E);
    }
    SEAM(8);
    float* LRS = (float*)(ms + MS_LRS); int* LTOK = (int*)(ms + MS_LTOK); float* LGATE = (float*)(ms + MS_LGATE);
    if (IN(9)) router_phase(lds, HB, (const bf16_t*)(ms + MS_WRB), SSP, LRS, LTOK, LGATE, (unsigned*)(ctl + CW_CNT), vcu, G);
    SEAM(9);
    volatile LAS unsigned* TMAP = (volatile LAS unsigned*)(lds + LDSCTL_OFF + 1024);
    if (hi > 10) moe_tables_fill((const unsigned*)(ctl + CW_CNT), MISC + 16, TMAP);
    const MoeTab MT0 = moe_tab(MISC + 16, TMAP, 0), MT1 = moe_tab(MISC + 16, TMAP, 1);
#define MT(k) ((k) ? MT1 : MT0)
    if (IN(10)) {
        SchedMoeUp S{MT(0), MT(1), G, bx, (const char*)(ws + WS_HB8), (const char*)(ws + WS_WEGU), LTOK, LRS};
        EpiSwigluMoe E{ws + WS_ACTE, LRS, MT(0), MT(1)};
        pg8::gemm_phase(lds, D, S, E);
    }
    SEAM(10);
    if (IN(11)) {
        SchedMoeDown S{MT(0), G, bx, 0, (const char*)(ws + WS_ACTE), (const char*)(ws + WS_WED), LTOK, LGATE, 0, 0}; S.init();
        EpiMoeDown<true> E{a.out, HB, LTOK, LGATE, MT(0), 0, (float*)(ws + WS_PART)};
        pg8::gemm_phase(lds, DFE, S, E);
    }
    SEAM(11);
    if (IN(12)) moe_reduce<true>(MT(0), 0, G, a.out, HB, LTOK, LGATE, (const float*)(ws + WS_PART), vcu * NWAVES + (tid >> 6), G * NWAVES, tid & 63);
    SEAM(12);
    if (IN(13)) {
        SchedMoeDown S{MT(1), G, bx, 1, (const char*)(ws + WS_ACTE + ACTE_BYTES), (const char*)(ws + WS_WED), LTOK, LGATE, 0, 0}; S.init();
        EpiMoeDown<false> E{a.out, HB, LTOK, LGATE, MT(1), 1, (float*)(ws + WS_PART)};
        pg8::gemm_phase(lds, DFE, S, E);
    }
    SEAM(13);
    if (IN(14)) moe_reduce<false>(MT(1), 1, G, a.out, HB, LTOK, LGATE, (const float*)(ws + WS_PART), vcu * NWAVES + (tid >> 6), G * NWAVES, tid & 63);
#undef MT
#undef IN
#undef SEAM
}

#ifdef DUMP_OFF
__global__ void dump_bf16(const bf16_t* src, float* out, size_t n) { for (size_t i = (size_t)blockIdx.x * blockDim.x + threadIdx.x; i < n; i += (size_t)gridDim.x * blockDim.x) out[i] = __uint_as_float((unsigned)src[i] << 16); }
#endif
extern "C" void kernel_launch(void* const* d_in, const int* in_sizes, int n_in, void* d_out, int out_size, void* d_ws, size_t ws_size, hipStream_t stream) {
    static int grid = 0;
    if (grid == 0) {
        if (n_in != 21 || in_sizes[0] != M * D || out_size != M * D || ws_size < WS_END) { fprintf(stderr, "kernel_launch: unexpected shapes (n_in %d, in0 %d, out %d, ws %zu < %zu); nothing launched\n", n_in, n_in > 0 ? in_sizes[0] : -1, out_size, ws_size, (size_t)WS_END); grid = -1; return; }
        int dev = 0, cus = 0, per_cu = 0;
        if (hipGetDevice(&dev) != hipSuccess || hipDeviceGetAttribute(&cus, hipDeviceAttributeMultiprocessorCount, dev) != hipSuccess) { grid = -1; return; }
        if (hipFuncSetAttribute((const void*)fwd_kernel, hipFuncAttributeMaxDynamicSharedMemorySize, LDS_BYTES) != hipSuccess) { fprintf(stderr, "kernel_launch: hipFuncSetAttribute failed\n"); grid = -1; return; }
        if (hipOccupancyMaxActiveBlocksPerMultiprocessor(&per_cu, (const void*)fwd_kernel, NTHREADS, LDS_BYTES) != hipSuccess || per_cu < 1) { fprintf(stderr, "kernel_launch: occupancy query reports %d workgroups per CU\n", per_cu); }
        (void)hipGetLastError();
        grid = cus;
    }
    if (grid < 0) return;
    if (hipMemsetAsync((char*)d_ws + WS_CTL, 0, CTL_ZERO_BYTES, stream) != hipSuccess) return;
    Args a{};
    for (int i = 0; i < 21; ++i) a.in[i] = (const float*)d_in[i];
    a.out = (float*)d_out; a.ws = (unsigned char*)d_ws;
#if MK_PER_PHASE
    for (int p = 0; p < N_PHASES; ++p) { a.ph_lo = p; a.ph_hi = p + 1; hipLaunchKernelGGL(fwd_kernel, dim3(grid), dim3(NTHREADS), LDS_BYTES, stream, a); }
#ifdef DUMP_OFF
    hipLaunchKernelGGL(dump_bf16, dim3(2048), dim3(256), 0, stream, (const bf16_t*)((const char*)d_ws + (DUMP_OFF)), (float*)d_out, (size_t)(DUMP_N));
#endif
#else
    a.ph_lo = 0; a.ph_hi = N_PHASES; hipLaunchKernelGGL(fwd_kernel, dim3(grid), dim3(NTHREADS), LDS_BYTES, stream, a);
#endif
}
```

```cpp
#include <hip/hip_runtime.h>
#include <cstdio>
#include <cstdint>

#define LAS __attribute__((address_space(3)))
#define GAS __attribute__((address_space(1)))
typedef unsigned short bf16_t;
typedef short bf16x8 __attribute__((ext_vector_type(8)));
typedef short s16x4 __attribute__((ext_vector_type(4)));
typedef float f32x2 __attribute__((ext_vector_type(2)));
typedef float f32x4 __attribute__((ext_vector_type(4)));
typedef float f32x16 __attribute__((ext_vector_type(16)));
typedef unsigned u32x2 __attribute__((ext_vector_type(2)));
typedef unsigned u32x4 __attribute__((ext_vector_type(4)));
typedef GAS unsigned gu32;

constexpr int D = 1024, NBATCH = 16, SEQ = 2048, M = NBATCH * SEQ, NMETA = 16;
constexpr int LP = 2176;
constexpr int PADP = 112;
constexpr int DIN = 1792, DFF = 2816, NE = 8, DFE = 3584;
constexpr int ZQA = 0, ZKA = 512, ZVA = 640, ZQB = 768, ZKB = 1024, ZVB = 1280, ZUC = 1536;
constexpr float EPS = 1e-6f, NEGF = -1e30f, LOG2E = 1.4426950408889634f;
constexpr int NWAVES = 8, NTHREADS = 512;

constexpr size_t MiB = 1u << 20;
constexpr size_t WS_CTL = 0, CTL_ZERO_BYTES = 96 * 1024;
constexpr size_t WS_WEGU = 1 * MiB;
constexpr size_t WS_WED = WS_WEGU + (size_t)NE * 2 * DFE * D;
constexpr size_t WS_HB8 = WS_WED + (size_t)NE * D * DFE;
constexpr size_t WS_MISC = WS_HB8 + (size_t)M * D;
constexpr size_t WS_R = WS_MISC + 10 * MiB;
constexpr size_t WS_HB = WS_R;
constexpr size_t WS_Z = WS_HB + (size_t)M * D * 2;
constexpr size_t Z_BYTES = (size_t)NBATCH * LP * DIN * 2;
constexpr size_t WS_MIX = WS_Z + ((Z_BYTES + MiB - 1) / MiB) * MiB;
constexpr size_t WS_WIN = WS_MIX + (size_t)M * D * 2;
constexpr size_t WS_WOUT = WS_WIN + (size_t)2 * DIN * D * 2;
constexpr size_t WS_WGU = WS_WOUT + (size_t)2 * D * D * 2;
constexpr size_t WS_WD = WS_WGU + (size_t)2 * DFF * D * 2;
constexpr size_t WS_ACT = WS_Z;
constexpr int ACTE_ROWS = M + NE * 256;
constexpr size_t ACTE_BYTES = (size_t)ACTE_ROWS * DFE;
constexpr size_t WS_ACTE = WS_Z;
constexpr size_t WS_PART = WS_ACTE + 2 * ACTE_BYTES;
constexpr size_t WS_END_A = WS_WD + (size_t)D * DFF * 2, WS_END_B = WS_PART + (size_t)224 * 65536 * 4;
constexpr size_t WS_END = WS_END_A > WS_END_B ? WS_END_A : WS_END_B;
static_assert(WS_ACT + (size_t)M * DFF * 2 <= WS_WIN, "dense hidden must not touch the converted weights");
constexpr int WEGU_SH = 5, WED_SH = 6, ACT_SH = 2;
constexpr size_t MS_SSP = 0;
constexpr size_t MS_LTOK = MS_SSP + (size_t)M * 16 * 4;
constexpr int LCAP = M + 256;
constexpr size_t MS_LGATE = MS_LTOK + (size_t)16 * LCAP * 4;
constexpr size_t MS_LRS = MS_LGATE + (size_t)16 * LCAP * 4;
constexpr size_t MS_HM = MS_LRS + (size_t)16 * LCAP * 4;
constexpr size_t MS_HMB = MS_HM + 16 * 1024 * 4;
constexpr size_t MS_SSPM = MS_HMB + 16 * 1024 * 2;
constexpr size_t MS_MIXM = MS_SSPM + 1024;
constexpr size_t MS_ACTM = MS_MIXM + 16 * 1024 * 2;
constexpr size_t MS_LUTA = MS_ACTM + 16 * 2816 * 2;
constexpr size_t MS_LUTB = MS_LUTA + 8 * 128 * 4;
constexpr size_t MS_WPT = MS_LUTB + 4 * 128 * 4;
constexpr size_t MS_WR = MS_WPT + 2 * 4 * 64 * 64 * 2;
constexpr size_t MS_END = MS_WR + 1024 * 8 * 4;
static_assert(MS_END <= 9 * MiB, "misc map");
constexpr int CW_BAR = 4096;
constexpr int CW_QUEUE = 16384;
constexpr int CW_CNT = 20480;
static_assert((CW_CNT + 64 * 32) * 4 <= (int)CTL_ZERO_BYTES && (CW_QUEUE + 64 * 24) <= CW_CNT, "control words inside the zeroed range");

__device__ __forceinline__ unsigned cvt_pk_bf16(float lo, float hi) { unsigned r; asm volatile("v_cvt_pk_bf16_f32 %0, %1, %2" : "=v"(r) : "v"(lo), "v"(hi)); return r; }
__device__ __forceinline__ unsigned pack4_fp8(float a, float b, float c, float d) { int w = 0; w = __builtin_amdgcn_cvt_pk_fp8_f32(a, b, w, false); w = __builtin_amdgcn_cvt_pk_fp8_f32(c, d, w, true); return (unsigned)w; }
__device__ __forceinline__ float bf16_lo(unsigned w) { return __uint_as_float(w << 16); }
__device__ __forceinline__ float bf16_hi(unsigned w) { return __uint_as_float(w & 0xffff0000u); }
template <int CTRL> __device__ __forceinline__ float dpp_mov(float v) { return __int_as_float(__builtin_amdgcn_update_dpp(0, __float_as_int(v), CTRL, 0xf, 0xf, true)); }
__device__ __forceinline__ float xor16_add(float v) { const auto r = __builtin_amdgcn_permlane16_swap(__float_as_uint(v), __float_as_uint(v), false, false); return __uint_as_float(r[0]) + __uint_as_float(r[1]); }
__device__ __forceinline__ float xor32_add(float v) { const auto r = __builtin_amdgcn_permlane32_swap(__float_as_uint(v), __float_as_uint(v), false, false); return __uint_as_float(r[0]) + __uint_as_float(r[1]); }
__device__ __forceinline__ float xor32_max(float v) { const auto r = __builtin_amdgcn_permlane32_swap(__float_as_uint(v), __float_as_uint(v), false, false); return fmaxf(__uint_as_float(r[0]), __uint_as_float(r[1])); }
__device__ __forceinline__ float wave_sum(float v) {
    v += dpp_mov<0xB1>(v);
    v += dpp_mov<0x4E>(v);
    v += dpp_mov<0x141>(v);
    v += dpp_mov<0x140>(v);
    return xor32_add(xor16_add(v));
}
#define LDS_WAIT() asm volatile("s_waitcnt lgkmcnt(0)" ::: "memory")
#define VM_WAIT() asm volatile("s_waitcnt vmcnt(0)" ::: "memory")
namespace pg8 {
constexpr int BM = 256, BK = 64, HALF = 128, HTB = HALF * BK * 2, STAGE_BYTES = 8 * HTB, NXCD = 8, WGM = 8;
constexpr int TOK_LDS_OFF = STAGE_BYTES;
constexpr int AUX_BUF = 4096;
constexpr int AUX_LDS_OFF = STAGE_BYTES + 1024;

__host__ __device__ __forceinline__ int lds_byte(int r, int c) { const int st = (r >> 4) * 2 + (c >> 5), rr = r & 15, cc = c & 31, ob = rr * 64 + cc * 2; return st * 1024 + (ob ^ (((ob >> 9) & 1) << 5)); }
__host__ __device__ __forceinline__ void stage_rc(int b, int& R, int& C) { const int st = b / 1024, sb = b % 1024, swz = sb ^ (((sb >> 9) & 1) << 5); R = (st >> 1) * 16 + swz / 64; C = (st & 1) * 32 + (swz % 64) / 2; }
__host__ __device__ __forceinline__ int perm32(int rho) { const int n = rho >> 4, i = rho & 15; return 8 * (i >> 2) + 4 * n + (i & 3); }

typedef int v8i32 __attribute__((ext_vector_type(8))); typedef int v4i32 __attribute__((ext_vector_type(4)));
__device__ __forceinline__ v8i32 cat8(bf16x8 a, bf16x8 b) { const v4i32 x = __builtin_bit_cast(v4i32, a), y = __builtin_bit_cast(v4i32, b); return __builtin_shufflevector(x, y, 0, 1, 2, 3, 4, 5, 6, 7); }
__device__ __forceinline__ void mfma_fp8(f32x4& acc, const v8i32& w, const v8i32& x, int sw, int sx) {
    asm volatile("s_nop 1\n\tv_mfma_scale_f32_16x16x128_f8f6f4 %0, %1, %2, %0, %3, %4 op_sel_hi:[0,0,0]" : "+v"(acc) : "v"(w), "v"(x), "v"(sw), "v"(sx));
}
__device__ __forceinline__ void mfma_fp8_z(f32x4& acc, const v8i32& w, const v8i32& x, int sw, int sx) {
    asm volatile("s_nop 1\n\tv_mfma_scale_f32_16x16x128_f8f6f4 %0, %1, %2, 0, %3, %4 op_sel_hi:[0,0,0]" : "=&v"(acc) : "v"(w), "v"(x), "v"(sw), "v"(sx));
}
struct Unit { int pm, pn, aux, kc, slab; };

template <int NN> __device__ __forceinline__ void order_map(int nM, int L, int& pm, int& pn) {
    const int nwg = nM * NN;
    int wgid = L; { const int q = nwg >> 3, r = nwg & 7, xcd = wgid & 7, off = wgid >> 3; wgid = (xcd < r ? xcd * (q + 1) : r * (q + 1) + (xcd - r) * q) + off; }
    constexpr int nig = WGM * NN; const int gid = wgid / nig, fm = gid * WGM, rem = wgid - gid * nig;
    if (fm + WGM <= nM) { pm = fm + (rem & (WGM - 1)); pn = rem / WGM; }
    else { pm = fm + rem / NN; pn = rem % NN; }
}
template <int NN> __device__ __forceinline__ bool static_order(int nM, int G, int c, int i, int& pm, int& pn) {
    const int L = i * G + c; if (L >= nM * NN) return false;
    order_map<NN>(nM, L, pm, pn); return true;
}

template <class Epi, class Sched>
__device__ __forceinline__ void gemm_phase(LAS unsigned char* lds, const int KB  , const Sched& S, const Epi& E) {
    const int tid = threadIdx.x, wid = __builtin_amdgcn_readfirstlane(tid >> 6), lane = tid & 63, wr = wid >> 2, wc = wid & 3, fr = lane & 15, fq = lane >> 4;
    const int nt = KB / 128;
    constexpr bool G = Sched::GATHER;
    unsigned voffB[2], aoC[2][2], aoN[2][2]; int rowA[2]; unsigned colA[2];
    const unsigned hstep = (unsigned)HALF * KB;
#pragma unroll
    for (int i = 0; i < 2; ++i) { int R, C; stage_rc(tid * 16 + i * 8192, R, C); const int Rb = (R & ~31) + perm32(R & 31);
        voffB[i] = (unsigned)(Rb * KB + C * 2); rowA[i] = R; colA[i] = (unsigned)C * 2u;
        aoC[0][i] = (unsigned)(R * KB + C * 2); aoC[1][i] = aoC[0][i] + hstep; aoN[0][i] = aoC[0][i]; aoN[1][i] = aoC[1][i]; }
    const size_t kstep = (size_t)(BK * 2);
    const unsigned ldsw = (unsigned)wid * 1024u;
    const int aoff = lds_byte(wr * 64 + fr, fq * 8), boff = lds_byte(wc * 32 + fr, fq * 8);
#define PG8_SA(b, h) (((b) * 2 + (h)) * HTB)
#define PG8_SB(b, h) ((4 + (b) * 2 + (h)) * HTB)
#define PG8_STAGE2(bufoff, gbase, o0, o1) do { \
        __builtin_amdgcn_global_load_lds((const unsigned*)((const char*)(gbase) + (o0)), (LAS unsigned*)(lds + (bufoff) + ldsw), 16, 0, 0); \
        __builtin_amdgcn_global_load_lds((const unsigned*)((const char*)(gbase) + (o1)), (LAS unsigned*)(lds + (bufoff) + ldsw + 8192), 16, 0, 0); } while (0)
#define PG8_STB(bufoff, gbase) PG8_STAGE2(bufoff, gbase, voffB[0], voffB[1])
#define PG8_LDA(dst, b, h) do { _Pragma("unroll") for (int m = 0; m < 4; ++m) { if constexpr (Sched::FP8) dst##8[m] = cat8(*(const LAS bf16x8*)(lds + PG8_SA(b, h) + aoff + m * 2048), *(const LAS bf16x8*)(lds + PG8_SA(b, h) + aoff + m * 2048 + 1024)); \
        else { _Pragma("unroll") for (int k = 0; k < 2; ++k) dst[m][k] = *(const LAS bf16x8*)(lds + PG8_SA(b, h) + aoff + m * 2048 + k * 1024); } } } while (0)
#define PG8_LDB(dst, b, h) do { _Pragma("unroll") for (int n = 0; n < 2; ++n) { if constexpr (Sched::FP8) dst##8[n] = cat8(*(const LAS bf16x8*)(lds + PG8_SB(b, h) + boff + n * 2048), *(const LAS bf16x8*)(lds + PG8_SB(b, h) + boff + n * 2048 + 1024)); \
        else { _Pragma("unroll") for (int k = 0; k < 2; ++k) dst[n][k] = *(const LAS bf16x8*)(lds + PG8_SB(b, h) + boff + n * 2048 + k * 1024); } } } while (0)
#define PG8_MMA(ai, bj, At, Bt, Z) do { __builtin_amdgcn_s_setprio(1); _Pragma("unroll") for (int m = 0; m < 4; ++m) _Pragma("unroll") for (int n = 0; n < 2; ++n) { \
        if constexpr (Sched::FP8) { if constexpr (Z) mfma_fp8_z(acc[ai][bj][m][n], Bt##8[n], At##8[m], scale_w, scale_x); else mfma_fp8(acc[ai][bj][m][n], Bt##8[n], At##8[m], scale_w, scale_x); } \
        else { _Pragma("unroll") for (int k = 0; k < 2; ++k) acc[ai][bj][m][n] = __builtin_amdgcn_mfma_f32_16x16x32_bf16(Bt[n][k], At[m][k], (Z && k == 0) ? (f32x4){0.f, 0.f, 0.f, 0.f} : acc[ai][bj][m][n], 0, 0, 0); } } __builtin_amdgcn_s_setprio(0); } while (0)
#define PG8_WAIT_V(n) asm volatile("s_waitcnt vmcnt(" #n ")" ::: "memory")
#define PG8_WAIT_L(n) asm volatile("s_waitcnt lgkmcnt(" #n ")" ::: "memory")
#define PG8_BAR __builtin_amdgcn_s_barrier()
#define PG8_SCHED __builtin_amdgcn_sched_barrier(0)
    Unit cur, nxt; int ui = 0;
    if (!S.next(0, cur)) return;
    int scale_w = Sched::SCALE_W, scale_x = Sched::SCALE_X; asm volatile("" : "+v"(scale_w), "+v"(scale_x));
    f32x4 acc[2][2][4][2];
#define PG8_ZERO_ACC do { if constexpr (!Sched::FP8) { _Pragma("unroll") for (int a = 0; a < 2; ++a) _Pragma("unroll") for (int b = 0; b < 2; ++b) _Pragma("unroll") for (int m = 0; m < 4; ++m) _Pragma("unroll") for (int n = 0; n < 2; ++n) { double z0, z1; asm volatile("v_mov_b64 %0, 0" : "=v"(z0)); asm volatile("v_mov_b64 %0, 0" : "=v"(z1)); const f32x2 p0 = __builtin_bit_cast(f32x2, z0), p1 = __builtin_bit_cast(f32x2, z1); acc[a][b][m][n] = (f32x4){p0[0], p0[1], p1[0], p1[1]}; } } } while (0)
    PG8_ZERO_ACC;
    bf16x8 At[4][2], B0[2][2], B1[2][2]; v8i32 At8[4], B08[2], B18[2];
    const char* cA = S.a_ptr(cur); const char* cB = S.b_ptr(cur);
    if constexpr (G) {
        const int* lp = S.list_ptr(cur); const int cnt = S.list_cnt(cur);
#pragma unroll
        for (int h = 0; h < 2; ++h)
#pragma unroll
            for (int i = 0; i < 2; ++i) { const int r = rowA[i] + HALF * h; const int id = r < cnt ? lp[r] : 0; aoC[h][i] = (unsigned)id * (unsigned)KB + colA[i]; }
    }
    if constexpr (Sched::AUX_OPS > 0) { if (wid >= 1 && wid <= Sched::AUX_OPS) __builtin_amdgcn_global_load_lds((const unsigned*)(S.aux_ptr(cur, wid - 1) + lane * 4), (LAS unsigned*)(lds + AUX_LDS_OFF + (wid - 1) * 1024), 16, 0, 0); }
    PG8_STB(PG8_SB(0, 0), cB); PG8_STB(PG8_SB(0, 1), cB + hstep); PG8_STAGE2(PG8_SA(0, 0), cA, aoC[0][0], aoC[0][1]); PG8_STAGE2(PG8_SA(0, 1), cA, aoC[1][0], aoC[1][1]);
    if (wr == 1) PG8_BAR;
    PG8_WAIT_V(2); PG8_BAR;
    PG8_STB(PG8_SB(1, 0), cB + kstep); PG8_STAGE2(PG8_SA(1, 0), cA + kstep, aoC[0][0], aoC[0][1]); PG8_STB(PG8_SB(1, 1), cB + hstep + kstep);
    PG8_WAIT_V(6); PG8_BAR;
    for (;;) {
        const bool has_next = S.next(ui + 1, nxt);
        int ntc = nt; if constexpr (Sched::VARK) ntc = S.nt_of(cur);
        const char* nA = has_next ? S.a_ptr(nxt) : cA; const char* nB = has_next ? S.b_ptr(nxt) : cB;
        int ncnt = 0;
        if constexpr (G) {
            if (has_next) { ncnt = S.list_cnt(nxt); if (wid == 0) __builtin_amdgcn_global_load_lds((const unsigned*)(S.list_ptr(nxt) + lane * 4), (LAS unsigned*)(lds + TOK_LDS_OFF), 16, 0, 0); }
        }
        if constexpr (Sched::AUX_OPS > 0) {
            if (has_next && wid >= 1 && wid <= Sched::AUX_OPS) __builtin_amdgcn_global_load_lds((const unsigned*)(S.aux_ptr(nxt, wid - 1) + lane * 4), (LAS unsigned*)(lds + AUX_LDS_OFF + ((ui + 1) % 3) * AUX_BUF + (wid - 1) * 1024), 16, 0, 0);
        }
#define PG8_TRIP(Z) do { \
            const bool last = (t == ntc - 2); \
            if constexpr (G) { \
                if (last && has_next) { \
                    const LAS int* tl = (const LAS int*)(lds + TOK_LDS_OFF); \
_Pragma("unroll") \
                    for (int h = 0; h < 2; ++h) \
_Pragma("unroll") \
                        for (int i = 0; i < 2; ++i) { const int r = rowA[i] + HALF * h; int id = tl[r]; id = r < ncnt ? id : 0; aoN[h][i] = (unsigned)id * (unsigned)KB + colA[i]; } \
                } else if (last) { \
_Pragma("unroll") \
                    for (int h = 0; h < 2; ++h) \
_Pragma("unroll") \
                        for (int i = 0; i < 2; ++i) aoN[h][i] = aoC[h][i]; \
                } \
            } \
            const char* a1 = cA + (size_t)(t + 1) * kstep; \
            const char* a2 = last ? nA : cA + (size_t)(t + 2) * kstep; const char* b2 = last ? nB : cB + (size_t)(t + 2) * kstep; \
            const char* a3 = a2 + kstep; const char* b3 = b2 + kstep; \
            unsigned o2[2][2]; \
_Pragma("unroll") \
            for (int h = 0; h < 2; ++h) \
_Pragma("unroll") \
                for (int i = 0; i < 2; ++i) o2[h][i] = (G && last) ? aoN[h][i] : aoC[h][i]; \
            PG8_LDB(B0, 0, 0); PG8_LDB(B1, 0, 1); PG8_SCHED; PG8_LDA(At, 0, 0); PG8_STAGE2(PG8_SA(1, 1), a1, aoC[1][0], aoC[1][1]); \
            PG8_WAIT_V(8); PG8_WAIT_L(0); PG8_BAR; PG8_MMA(0, 0, At, B0, Z); PG8_MMA(0, 1, At, B1, Z); PG8_BAR; PG8_SCHED; \
            PG8_LDA(At, 0, 1); PG8_STB(PG8_SB(0, 0), b2); PG8_STB(PG8_SB(0, 1), b2 + hstep); PG8_STAGE2(PG8_SA(0, 0), a2, o2[0][0], o2[0][1]); \
            PG8_WAIT_V(8); PG8_WAIT_L(0); PG8_BAR; PG8_MMA(1, 0, At, B0, Z); PG8_MMA(1, 1, At, B1, Z); PG8_BAR; PG8_SCHED; \
            PG8_LDB(B0, 1, 0); PG8_LDB(B1, 1, 1); PG8_SCHED; PG8_LDA(At, 1, 0); PG8_STAGE2(PG8_SA(0, 1), a2, o2[1][0], o2[1][1]); \
            PG8_WAIT_V(8); PG8_WAIT_L(0); PG8_BAR; PG8_MMA(0, 0, At, B0, 0); PG8_MMA(0, 1, At, B1, 0); PG8_BAR; PG8_SCHED; \
            PG8_LDA(At, 1, 1); PG8_STB(PG8_SB(1, 0), b3); PG8_STB(PG8_SB(1, 1), b3 + hstep); PG8_STAGE2(PG8_SA(1, 0), a3, o2[0][0], o2[0][1]); \
            PG8_WAIT_V(8); PG8_WAIT_L(0); PG8_BAR; PG8_MMA(1, 0, At, B0, 0); PG8_MMA(1, 1, At, B1, 0); PG8_BAR; PG8_SCHED; \
        } while (0)
        if constexpr (Sched::FP8) { int t = 0; PG8_TRIP(1); for (t = 2; t < ntc; t += 2) PG8_TRIP(0); }
        else { for (int t = 0; t < ntc; t += 2) PG8_TRIP(0); }
#undef PG8_TRIP
        if (wr == 0) PG8_BAR;
        E(acc, cur, wr, wc, fr, fq, lds + AUX_LDS_OFF + (ui % 3) * AUX_BUF);
#ifdef EPI_TWICE
        if constexpr (Epi::IDEMPOTENT) { asm volatile("" ::: "memory"); E(acc, cur, wr, wc, fr, fq, lds + AUX_LDS_OFF + (ui % 3) * AUX_BUF); }
#endif
        if (!has_next) break;
        PG8_ZERO_ACC;
        cur = nxt; cA = nA; cB = nB; ++ui;
        if constexpr (G) {
#pragma unroll
            for (int h = 0; h < 2; ++h)
#pragma unroll
                for (int i = 0; i < 2; ++i) aoC[h][i] = aoN[h][i];
        }
        if (wr == 1) PG8_BAR;
    }
    PG8_WAIT_V(0);
    PG8_BAR;
#undef PG8_ZERO_ACC
#undef PG8_SA
#undef PG8_SB
#undef PG8_STAGE2
#undef PG8_STB
#undef PG8_LDA
#undef PG8_LDB
#undef PG8_MMA
#undef PG8_WAIT_V
#undef PG8_WAIT_L
#undef PG8_BAR
#undef PG8_SCHED
}
}
using pg8::Unit;
typedef f32x4 AccT[2][2][4][2];

__device__ __forceinline__ float rstd_from_aux(const LAS unsigned char* aux, int r) {
    const f32x4 a = *((const LAS f32x4*)aux + r); return __builtin_amdgcn_rsqf(((a[0] + a[1]) + (a[2] + a[3])) * (1.0f / D) + EPS);
}
__device__ __forceinline__ float rstd_from_ssp(const float* ssp, int row) {
    const f32x4* p = (const f32x4*)(ssp + (size_t)row * 16); const f32x4 a = p[0], b = p[1], c = p[2], d = p[3];
    const float s = ((a[0] + a[1]) + (a[2] + a[3])) + ((b[0] + b[1]) + (b[2] + b[3])) + ((c[0] + c[1]) + (c[2] + c[3])) + ((d[0] + d[1]) + (d[2] + d[3]));
    return __builtin_amdgcn_rsqf(s * (1.0f / D) + EPS);
}

template <int AUXN, int NN> struct SchedDenseT {
    static constexpr bool GATHER = false, VARK = false, FP8 = false; static constexpr int SCALE_W = 127, SCALE_X = 127, AUX_OPS = AUXN;
    int nM, G, c; const char* A; const char* B; size_t tstep; const float* ssp4;
    __device__ __forceinline__ const float* aux_ptr(const Unit& u, int w) const { return ssp4 + (size_t)u.pm * 1024 + w * 256; }
    __device__ __forceinline__ bool next(int i, Unit& u) const { u.aux = 0; u.kc = -1; u.slab = 0; return pg8::static_order<NN>(nM, G, c, i, u.pm, u.pn); }
    __device__ __forceinline__ const char* a_ptr(const Unit& u) const { return A + (size_t)u.pm * tstep; }
    __device__ __forceinline__ const char* b_ptr(const Unit& u) const { return B + (size_t)u.pn * tstep; }
};

struct MoeTab { const LAS int* ts; const LAS int* cnt; const LAS int* tile; int nM; };
__device__ __forceinline__ int moe_expert_of(const MoeTab& T, int j) { int e = 0;
#pragma unroll
    for (int x = 1; x < 8; ++x) e += (j >= T.ts[x]) ? 1 : 0;
    return e; }

constexpr int MOE_SPLIT = 7, MOE_KC = DFE / MOE_SPLIT;
struct SchedMoeUp {
    static constexpr bool GATHER = true, VARK = false, FP8 = true; static constexpr int SCALE_W = 127 - WEGU_SH, SCALE_X = 127, AUX_OPS = 1, NN = 2 * DFE / 256;
    MoeTab T0, T1; int G, c; const char* A; const char* B; const int* ltok; const float* lrs;
    __device__ __forceinline__ bool next(int i, Unit& u) const {
        const int U0 = T0.nM * NN, U1 = T1.nM * NN; u.kc = -1; u.slab = 0;
        const int v = i * G + c; if (v >= U0 + U1) return false;
        const int k = v >= U0 ? 1 : 0;
        pg8::order_map<NN>(k ? T1.nM : T0.nM, v - (k ? U0 : 0), u.pm, u.pn);
        u.aux = (k << 30) | (k ? T1.tile : T0.tile)[u.pm]; return true; }
    __device__ __forceinline__ const char* a_ptr(const Unit&) const { return A; }
    __device__ __forceinline__ const char* b_ptr(const Unit& u) const { return B + ((size_t)((u.aux >> 16) & 7) * 2 * DFE + (size_t)u.pn * 256) * D; }
    __device__ __forceinline__ const int* list_ptr(const Unit& u) const { return ltok + (size_t)((u.aux >> 30) * 8 + ((u.aux >> 16) & 7)) * LCAP + (u.aux & 0xffff) * 256; }
    __device__ __forceinline__ const float* aux_ptr(const Unit& u, int) const { return lrs + (size_t)((u.aux >> 30) * 8 + ((u.aux >> 16) & 7)) * LCAP + (u.aux & 0xffff) * 256; }
    __device__ __forceinline__ int list_cnt(const Unit& u) const { const MoeTab& T = (u.aux >> 30) ? T1 : T0; const int r = T.cnt[(u.aux >> 16) & 7] - (u.aux & 0xffff) * 256; return r < 256 ? r : 256; }
};
struct SchedMoeDown {
    static constexpr bool GATHER = false, VARK = true, FP8 = true; static constexpr int SCALE_W = 127 - WED_SH, SCALE_X = 127 - ACT_SH, AUX_OPS = 2, NN = D / 256;
    MoeTab T; int G, c, k; const char* A; const char* B; const int* ltok; const float* lgate; int full, lf;
    __device__ __forceinline__ void init() { const int U = T.nM * NN; full = (U / G) * G; lf = U - full; }
    __device__ __forceinline__ bool next(int i, Unit& u) const {
        u.kc = -1; u.slab = 0;
        const int v = i * G + c; int L;
        if (v >= full + lf * MOE_SPLIT) return false;
        if (v < full) L = v; else { const int lo = v - full; L = full + lo / MOE_SPLIT; u.kc = lo % MOE_SPLIT; u.slab = lo; }
        pg8::order_map<NN>(T.nM, L, u.pm, u.pn);
        u.aux = T.tile[u.pm]; return true; }
    __device__ __forceinline__ const float* aux_ptr(const Unit& u, int w) const { const size_t lo = (size_t)(k * 8 + (u.aux >> 16)) * LCAP + (u.aux & 0xffff) * 256; return w ? lgate + lo : (const float*)(ltok + lo); }
    __device__ __forceinline__ int nt_of(const Unit& u) const { return u.kc >= 0 ? MOE_KC / 128 : DFE / 128; }
    __device__ __forceinline__ const char* a_ptr(const Unit& u) const { return A + (size_t)u.pm * 256 * DFE + (u.kc > 0 ? (size_t)u.kc * MOE_KC : 0); }
    __device__ __forceinline__ const char* b_ptr(const Unit& u) const { return B + ((size_t)(u.aux >> 16) * D + (size_t)u.pn * 256) * DFE + (u.kc > 0 ? (size_t)u.kc * MOE_KC : 0); }
};

struct EpiInProj {
    static constexpr bool IDEMPOTENT = true;
    bf16_t* Z; const float* ssp; const LAS float* gt;
    __device__ __forceinline__ void operator()(const AccT& acc, const Unit& u, int wr, int wc, int fr, int fq, const LAS unsigned char* aux) const {
        asm volatile("" : "+v"(fr), "+v"(fq));
        const int T = u.pn;
        int mode = 0; const LAS float* g = gt;
        if (T < 2) { mode = 1; g = gt; } else if (T == 2) { if (wc < 2) { mode = 1; g = gt + 64; } } else if (T == 3) { mode = 2; g = gt + 128; } else if (T == 4) { mode = 2; g = gt + 192; }
        f32x4 gv[2][2];
#pragma unroll
        for (int bj = 0; bj < 2; ++bj)
#pragma unroll
            for (int n = 0; n < 2; ++n) gv[bj][n] = mode == 0 ? (f32x4){1.f, 1.f, 1.f, 1.f} : *(const LAS f32x4*)(g + (mode == 1 ? 32 * bj : 0) + 8 * fq + 4 * n);
        const int row0 = u.pm * 256 + wr * 64 + fr;
        f32x4 qv[2][4];
#pragma unroll
        for (int ai = 0; ai < 2; ++ai)
#pragma unroll
            for (int m = 0; m < 4; ++m) qv[ai][m] = *((const LAS f32x4*)aux + (wr * 64 + fr + ai * 128 + m * 16));
#pragma unroll
        for (int ai = 0; ai < 2; ++ai)
#pragma unroll
            for (int m = 0; m < 4; ++m) {
                const int row = row0 + ai * 128 + m * 16; const f32x4 q4 = qv[ai][m]; const float rs = __builtin_amdgcn_rsqf(((q4[0] + q4[1]) + (q4[2] + q4[3])) * (1.0f / D) + EPS);
                f32x4 v[2][2]; float s0 = 0.f, s1 = 0.f;
#pragma unroll
                for (int n = 0; n < 2; ++n) { v[0][n] = acc[ai][0][m][n] * rs; v[1][n] = acc[ai][1][m][n] * rs;
                    s0 += (v[0][n][0] * v[0][n][0] + v[0][n][1] * v[0][n][1]) + (v[0][n][2] * v[0][n][2] + v[0][n][3] * v[0][n][3]);
                    s1 += (v[1][n][0] * v[1][n][0] + v[1][n][1] * v[1][n][1]) + (v[1][n][2] * v[1][n][2] + v[1][n][3] * v[1][n][3]); }
                float r0 = 1.f, r1 = 1.f;
                if (mode != 0) {
                    s0 = xor32_add(xor16_add(s0)); s1 = xor32_add(xor16_add(s1));
                    if (mode == 1) { r0 = r1 = __builtin_amdgcn_rsqf((s0 + s1) * (1.0f / 64.0f) + EPS); }
                    else { r0 = __builtin_amdgcn_rsqf(s0 * (1.0f / 32.0f) + EPS); r1 = __builtin_amdgcn_rsqf(s1 * (1.0f / 32.0f) + EPS); }
                }
                const int b = row >> 11, t = row & 2047;
                bf16_t* zp = Z + ((size_t)(b * LP + 128 + t)) * DIN + T * 256 + wc * 64 + 8 * fq;
#pragma unroll
                for (int bj = 0; bj < 2; ++bj) { const float rr = bj ? r1 : r0; const f32x4 a = v[bj][0] * gv[bj][0] * rr, c = v[bj][1] * gv[bj][1] * rr;
                    u32x4 w; w.x = cvt_pk_bf16(a[0], a[1]); w.y = cvt_pk_bf16(a[2], a[3]); w.z = cvt_pk_bf16(c[0], c[1]); w.w = cvt_pk_bf16(c[2], c[3]);
                    *(u32x4*)(zp + 32 * bj) = w; }
            }
    }
};

template <int MODE> struct EpiRes {
    static constexpr bool IDEMPOTENT = (MODE == 0);
    const float* res; bf16_t* hb; float* ssp; unsigned char* hb8; LAS float* rowsum;
    __device__ __forceinline__ void operator()(const AccT& acc, const Unit& u, int wr, int wc, int fr, int fq, const LAS unsigned char* aux) const {
        asm volatile("" : "+v"(fr), "+v"(fq));
        const int row0 = u.pm * 256 + wr * 64 + fr, col0 = u.pn * 256 + wc * 32 + 8 * fq;
#pragma unroll
        for (int ai = 0; ai < 2; ++ai) {
            u32x4 hv[4][2];
            if constexpr (MODE != 0) {
#pragma unroll
                for (int m = 0; m < 4; ++m)
#pragma unroll
                    for (int bj = 0; bj < 2; ++bj) hv[m][bj] = *(const u32x4*)(hb + (size_t)(row0 + ai * 128 + m * 16) * D + col0 + bj * 128);
                asm volatile("" ::: "memory");
            }
#pragma unroll
            for (int m = 0; m < 4; ++m) {
                const int row = row0 + ai * 128 + m * 16; const size_t off = (size_t)row * D + col0; float ss = 0.f;
#pragma unroll
                for (int bj = 0; bj < 2; ++bj) {
                    f32x4 a, c;
                    if constexpr (MODE == 0) { a = *(const f32x4*)(res + off + bj * 128); c = *(const f32x4*)(res + off + bj * 128 + 4); }
                    else { const u32x4 h = hv[m][bj]; a = (f32x4){bf16_lo(h.x), bf16_hi(h.x), bf16_lo(h.y), bf16_hi(h.y)}; c = (f32x4){bf16_lo(h.z), bf16_hi(h.z), bf16_lo(h.w), bf16_hi(h.w)}; }
                    a += acc[ai][bj][m][0]; c += acc[ai][bj][m][1];
                    u32x4 w; w.x = cvt_pk_bf16(a[0], a[1]); w.y = cvt_pk_bf16(a[2], a[3]); w.z = cvt_pk_bf16(c[0], c[1]); w.w = cvt_pk_bf16(c[2], c[3]);
                    *(u32x4*)(hb + off + bj * 128) = w;
                    if constexpr (MODE == 2) { u32x2 w8; w8.x = pack4_fp8(a[0], a[1], a[2], a[3]); w8.y = pack4_fp8(c[0], c[1], c[2], c[3]); *(u32x2*)(hb8 + off + bj * 128) = w8; }
                    ss += ((a[0] * a[0] + a[1] * a[1]) + (a[2] * a[2] + a[3] * a[3])) + ((c[0] * c[0] + c[1] * c[1]) + (c[2] * c[2] + c[3] * c[3])); }
                ss = xor32_add(xor16_add(ss));
                if (fq == 0) rowsum[(row - u.pm * 256) * 4 + wc] = ss;
            }
            asm volatile("" ::: "memory");
        }
        asm volatile("s_waitcnt lgkmcnt(0)" ::: "memory"); __builtin_amdgcn_s_barrier(); asm volatile("" ::: "memory");
        if (threadIdx.x < 256) { const f32x4 q = *((const LAS f32x4*)rowsum + threadIdx.x); ssp[(size_t)(u.pm * 256 + threadIdx.x) * 4 + u.pn] = (q[0] + q[1]) + (q[2] + q[3]); }
        asm volatile("s_waitcnt lgkmcnt(0)" ::: "memory"); __builtin_amdgcn_s_barrier(); asm volatile("" ::: "memory");
    }
};

__device__ __forceinline__ f32x4 swiglu4(f32x4 g, f32x4 u, float nrs, float irs2) {
    const f32x4 t = g * nrs; f32x4 e; e[0] = __builtin_amdgcn_exp2f(t[0]); e[1] = __builtin_amdgcn_exp2f(t[1]); e[2] = __builtin_amdgcn_exp2f(t[2]); e[3] = __builtin_amdgcn_exp2f(t[3]);
    const f32x4 d = e * irs2 + irs2; f32x4 r; r[0] = __builtin_amdgcn_rcpf(d[0]); r[1] = __builtin_amdgcn_rcpf(d[1]); r[2] = __builtin_amdgcn_rcpf(d[2]); r[3] = __builtin_amdgcn_rcpf(d[3]);
    return (g * u) * r;
}
__device__ __forceinline__ float silu_mul(float g, float u) { return g * __builtin_amdgcn_rcpf(1.0f + __builtin_amdgcn_exp2f(-g * LOG2E)) * u; }

struct EpiSwiglu {
    static constexpr bool IDEMPOTENT = true;
    bf16_t* act; const float* ssp;
    __device__ __forceinline__ void operator()(const AccT& acc, const Unit& u, int wr, int wc, int fr, int fq, const LAS unsigned char* aux) const {
        asm volatile("" : "+v"(fr), "+v"(fq));
        const int row0 = u.pm * 256 + wr * 64 + fr, col0 = u.pn * 128 + wc * 32 + 8 * fq;
        f32x4 qv[2][4];
#pragma unroll
        for (int ai = 0; ai < 2; ++ai)
#pragma unroll
            for (int m = 0; m < 4; ++m) qv[ai][m] = *((const LAS f32x4*)aux + (wr * 64 + fr + ai * 128 + m * 16));
#pragma unroll
        for (int ai = 0; ai < 2; ++ai)
#pragma unroll
            for (int m = 0; m < 4; ++m) {
                const int row = row0 + ai * 128 + m * 16; const f32x4 q4 = qv[ai][m]; const float rs = __builtin_amdgcn_rsqf(((q4[0] + q4[1]) + (q4[2] + q4[3])) * (1.0f / D) + EPS);
                const float nrs = -rs * LOG2E, irs2 = __builtin_amdgcn_rcpf(rs * rs);
                const f32x4 a0 = swiglu4(acc[ai][0][m][0], acc[ai][1][m][0], nrs, irs2), a1 = swiglu4(acc[ai][0][m][1], acc[ai][1][m][1], nrs, irs2);
                u32x4 w; w.x = cvt_pk_bf16(a0[0], a0[1]); w.y = cvt_pk_bf16(a0[2], a0[3]); w.z = cvt_pk_bf16(a1[0], a1[1]); w.w = cvt_pk_bf16(a1[2], a1[3]);
                __builtin_nontemporal_store(w, (u32x4*)(act + (size_t)row * DFF + col0));
            }
    }
};

struct EpiSwigluMoe {
    static constexpr bool IDEMPOTENT = true;
    unsigned char* act; const float* lrs; MoeTab T0, T1;
    __device__ __forceinline__ void operator()(const AccT& acc, const Unit& u, int wr, int wc, int fr, int fq, const LAS unsigned char* aux) const {
        asm volatile("" : "+v"(fr), "+v"(fq));
        const int k = u.aux >> 30, e = (u.aux >> 16) & 7, lt = u.aux & 0xffff; const MoeTab& T = k ? T1 : T0;
        const LAS float* lp = (const LAS float*)aux; const int cnt = T.cnt[e] - lt * 256;
        const int r0 = wr * 64 + fr, col0 = u.pn * 128 + wc * 32 + 8 * fq; constexpr float SC = (float)(1 << ACT_SH);
        unsigned char* abase = act; asm volatile("" : "+s"(abase));
        unsigned char* ab = abase + (size_t)k * ACTE_BYTES + (size_t)u.pm * 256 * DFE + col0;
        float rsv[2][4];
#pragma unroll
        for (int ai = 0; ai < 2; ++ai)
#pragma unroll
            for (int m = 0; m < 4; ++m) rsv[ai][m] = lp[r0 + ai * 128 + m * 16];
#pragma unroll
        for (int ai = 0; ai < 2; ++ai)
#pragma unroll
            for (int m = 0; m < 4; ++m) {
                const int r = r0 + ai * 128 + m * 16; const float rs = (r < cnt) ? rsv[ai][m] : 0.f;
                const float nrs = -rs * LOG2E, irs2 = __builtin_amdgcn_rcpf(rs * rs * SC);
                const f32x4 a0 = swiglu4(acc[ai][0][m][0], acc[ai][1][m][0], nrs, irs2), a1 = swiglu4(acc[ai][0][m][1], acc[ai][1][m][1], nrs, irs2);
                u32x2 w; w.x = pack4_fp8(a0[0], a0[1], a0[2], a0[3]); w.y = pack4_fp8(a1[0], a1[1], a1[2], a1[3]);
                __builtin_nontemporal_store(w, (u32x2*)(ab + (size_t)r * DFE));
            }
    }
};

template <bool FIRST> struct EpiMoeDown {
    static constexpr bool IDEMPOTENT = false;
    float* out; bf16_t* hb; const int* ltok; const float* lgate; MoeTab T; int k; float* part;
    __device__ __forceinline__ void operator()(const AccT& acc, const Unit& u, int wr, int wc, int fr, int fq, const LAS unsigned char* aux) const {
        asm volatile("" : "+v"(fr), "+v"(fq));
        const int r0 = wr * 64 + fr;
        if (u.kc >= 0) {
            float* pbase = part; asm volatile("" : "+s"(pbase));
            float* pp = pbase + (size_t)u.slab * 65536 + wc * 32 + 8 * fq;
#pragma unroll
            for (int ai = 0; ai < 2; ++ai)
#pragma unroll
                for (int m = 0; m < 4; ++m) { float* rp = pp + (size_t)(r0 + ai * 128 + m * 16) * 256;
#pragma unroll
                    for (int bj = 0; bj < 2; ++bj) { *(f32x4*)(rp + bj * 128) = acc[ai][bj][m][0]; *(f32x4*)(rp + bj * 128 + 4) = acc[ai][bj][m][1]; } }
            return;
        }
        const int e = u.aux >> 16, lt = u.aux & 0xffff; const size_t lo = (size_t)(k * 8 + e) * LCAP + lt * 256; const int cnt = T.cnt[e] - lt * 256;
        const int col0 = u.pn * 256 + wc * 32 + 8 * fq;
#pragma unroll
        for (int ai = 0; ai < 2; ++ai) {
            int tk[4]; float gg[4]; u32x4 hv[4][2];
#pragma unroll
            for (int m = 0; m < 4; ++m) { const int r = r0 + ai * 128 + m * 16; const bool ok = r < cnt; tk[m] = ok ? ((const LAS int*)aux)[r] : 0; gg[m] = ok ? ((const LAS float*)aux)[256 + r] : 0.f; }
#pragma unroll
            for (int m = 0; m < 4; ++m)
#pragma unroll
                for (int bj = 0; bj < 2; ++bj) hv[m][bj] = *(const u32x4*)(hb + (size_t)tk[m] * D + col0 + bj * 128);
            asm volatile("" ::: "memory");
#pragma unroll
            for (int m = 0; m < 4; ++m) {
                const int r = r0 + ai * 128 + m * 16;
                if (r < cnt) { const int tok = tk[m]; const float g = gg[m]; float* op = out + (size_t)tok * D + col0; bf16_t* hp = hb + (size_t)tok * D + col0;
#pragma unroll
                    for (int bj = 0; bj < 2; ++bj) { const u32x4 h = hv[m][bj];
                        const f32x4 a = (f32x4){bf16_lo(h.x), bf16_hi(h.x), bf16_lo(h.y), bf16_hi(h.y)} + acc[ai][bj][m][0] * g, c = (f32x4){bf16_lo(h.z), bf16_hi(h.z), bf16_lo(h.w), bf16_hi(h.w)} + acc[ai][bj][m][1] * g;
                        if constexpr (FIRST) { u32x4 w; w.x = cvt_pk_bf16(a[0], a[1]); w.y = cvt_pk_bf16(a[2], a[3]); w.z = cvt_pk_bf16(c[0], c[1]); w.w = cvt_pk_bf16(c[2], c[3]); *(u32x4*)(hp + bj * 128) = w; }
                        else { *(f32x4*)(op + bj * 128) = a; *(f32x4*)(op + bj * 128 + 4) = c; } } }
            }
            asm volatile("" ::: "memory");
        }
    }
};

template <bool FIRST> __device__ __forceinline__ void moe_reduce(const MoeTab& T, int k, int G, float* out, bf16_t* hb, const int* ltok, const float* lgate, const float* part, int gw, int NGW, int lane) {
    const int nM = T.nM, U = nM * 4, full = (U / G) * G, lf = U - full, total = lf * 256;
    for (int base = gw; base < total; base += 4 * NGW) {
        int tok[4], pnv[4], jv[4], rv[4]; float g[4]; bool ok[4];
#pragma unroll
        for (int i = 0; i < 4; ++i) { const int w = base + i * NGW; ok[i] = w < total; const int ww = ok[i] ? w : base; jv[i] = ww >> 8; rv[i] = ww & 255; int pm; pg8::order_map<4>(nM, full + jv[i], pm, pnv[i]);
            const int tw = T.tile[pm], e = tw >> 16, lt = tw & 0xffff, cnt = T.cnt[e] - lt * 256; ok[i] = ok[i] && rv[i] < cnt;
            const size_t lo = (size_t)(k * 8 + e) * LCAP + lt * 256 + (ok[i] ? rv[i] : 0); tok[i] = ok[i] ? ltok[lo] : 0; g[i] = ok[i] ? lgate[lo] : 0.f; }
        f32x4 s[4]; u32x2 h[4];
#pragma unroll
        for (int i = 0; i < 4; ++i) { s[i] = (f32x4){0.f, 0.f, 0.f, 0.f};
#pragma unroll
            for (int c = 0; c < MOE_SPLIT; ++c) s[i] += *((const f32x4*)(part + (size_t)(jv[i] * MOE_SPLIT + c) * 65536 + (size_t)rv[i] * 256) + lane);
            h[i] = *((const u32x2*)(hb + (size_t)tok[i] * D + pnv[i] * 256) + lane); }
        asm volatile("" ::: "memory");
#pragma unroll
        for (int i = 0; i < 4; ++i) if (ok[i]) {
            const f32x4 v = (f32x4){bf16_lo(h[i].x), bf16_hi(h[i].x), bf16_lo(h[i].y), bf16_hi(h[i].y)} + s[i] * g[i];
            if constexpr (FIRST) { u32x2 w; w.x = cvt_pk_bf16(v[0], v[1]); w.y = cvt_pk_bf16(v[2], v[3]); *((u32x2*)(hb + (size_t)tok[i] * D + pnv[i] * 256) + lane) = w; }
            else *((f32x4*)(out + (size_t)tok[i] * D + pnv[i] * 256) + lane) = v; }
    }
}
__device__ __forceinline__ bool skinny16(LAS unsigned char* lds, const bf16_t* A, const bf16_t* Bt, int K, const int (&rowbase)[4], f32x4 (&acc)[4]) {
    const int tid = threadIdx.x, wid = __builtin_amdgcn_readfirstlane(tid >> 6), lane = tid & 63, fr = lane & 15, kq = lane >> 4;
    const int kw = K / 8, k0 = wid * kw;
#pragma unroll
    for (int cb = 0; cb < 4; ++cb) acc[cb] = (f32x4){0.f, 0.f, 0.f, 0.f};
    const bf16_t* ap = A + (size_t)fr * K + k0 + 8 * kq;
    const bf16_t* bp[4];
#pragma unroll
    for (int cb = 0; cb < 4; ++cb) bp[cb] = Bt + (size_t)(rowbase[cb] + fr) * K + k0 + 8 * kq;
    for (int s0 = 0; s0 < kw; s0 += 128) {
        bf16x8 a[4], b[4][4];
#pragma unroll
        for (int i = 0; i < 4; ++i) { const int s = (s0 + 32 * i < kw) ? s0 + 32 * i : s0; a[i] = *(const bf16x8*)(ap + s);
#pragma unroll
            for (int cb = 0; cb < 4; ++cb) b[i][cb] = *(const bf16x8*)(bp[cb] + s); }
#pragma unroll
        for (int i = 0; i < 4; ++i) if (s0 + 32 * i < kw) {
#pragma unroll
            for (int cb = 0; cb < 4; ++cb) acc[cb] = __builtin_amdgcn_mfma_f32_16x16x32_bf16(b[i][cb], a[i], acc[cb], 0, 0, 0); }
    }
    LAS f32x4* scr = (LAS f32x4*)lds;
#pragma unroll
    for (int cb = 0; cb < 4; ++cb) scr[(wid * 4 + cb) * 64 + lane] = acc[cb];
    __syncthreads();
    if (wid == 0) {
#pragma unroll
        for (int cb = 0; cb < 4; ++cb) { f32x4 s = scr[cb * 64 + lane];
#pragma unroll
            for (int w = 1; w < 8; ++w) s += scr[(w * 4 + cb) * 64 + lane];
            acc[cb] = s; }
    }
    __syncthreads();
    return wid == 0;
}

__device__ __forceinline__ void meta_inproj_unit(LAS unsigned char* lds, int j, const bf16_t* hmb, const bf16_t* win, const float* sspm, const float* gt, bf16_t* Z) {
    const int T = j >> 2, h = j & 3; const int rb[4] = {T * 256 + 32 * h, T * 256 + 32 * h + 16, T * 256 + 128 + 32 * h, T * 256 + 128 + 32 * h + 16};
    f32x4 acc[4];
    if (!skinny16(lds, hmb, win, D, rb, acc)) return;
    const int lane = threadIdx.x & 63, fr = lane & 15, fq = lane >> 4;
    const float rs = rstd_from_ssp(sspm, fr);
    int mode = 0; const float* g = gt;
    if (T < 2) { mode = 1; } else if (T == 2) { if (h < 2) { mode = 1; g = gt + 64; } } else if (T == 3) { mode = 2; g = gt + 128; } else if (T == 4) { mode = 2; g = gt + 192; }
    float s0 = 0.f, s1 = 0.f;
#pragma unroll
    for (int cb = 0; cb < 4; ++cb) { acc[cb] = acc[cb] * rs; const float q = (acc[cb][0] * acc[cb][0] + acc[cb][1] * acc[cb][1]) + (acc[cb][2] * acc[cb][2] + acc[cb][3] * acc[cb][3]); if (cb < 2) s0 += q; else s1 += q; }
    float r0 = 1.f, r1 = 1.f;
    if (mode != 0) {
        s0 = xor32_add(xor16_add(s0)); s1 = xor32_add(xor16_add(s1));
        if (mode == 1) { r0 = r1 = __builtin_amdgcn_rsqf((s0 + s1) * (1.0f / 64.0f) + EPS); }
        else { r0 = __builtin_amdgcn_rsqf(s0 * (1.0f / 32.0f) + EPS); r1 = __builtin_amdgcn_rsqf(s1 * (1.0f / 32.0f) + EPS); }
    }
#pragma unroll
    for (int cb = 0; cb < 4; ++cb) { const int c = cb >> 1, jc = 16 * (cb & 1) + 4 * fq;
        f32x4 v = acc[cb] * (c ? r1 : r0);
        if (mode != 0) v = v * *(const f32x4*)(g + (mode == 1 ? 32 * c : 0) + jc);
        u32x2 w; w.x = cvt_pk_bf16(v[0], v[1]); w.y = cvt_pk_bf16(v[2], v[3]);
        for (int b = 0; b < NBATCH; ++b) *(u32x2*)(Z + ((size_t)(b * LP + PADP + fr)) * DIN + T * 256 + 64 * h + 32 * c + jc) = w; }
}

__device__ __forceinline__ void meta_res_unit(LAS unsigned char* lds, int j, const bf16_t* A, const bf16_t* Bt, int K, float* hm, bf16_t* hmb, float* sspm) {
    const int rb[4] = {64 * j, 64 * j + 16, 64 * j + 32, 64 * j + 48};
    f32x4 acc[4];
    if (!skinny16(lds, A, Bt, K, rb, acc)) return;
    const int lane = threadIdx.x & 63, fr = lane & 15, fq = lane >> 4; float ss = 0.f;
#pragma unroll
    for (int cb = 0; cb < 4; ++cb) { const size_t off = (size_t)fr * D + 64 * j + 16 * cb + 4 * fq; const f32x4 v = *(const f32x4*)(hm + off) + acc[cb];
        *(f32x4*)(hm + off) = v; u32x2 w; w.x = cvt_pk_bf16(v[0], v[1]); w.y = cvt_pk_bf16(v[2], v[3]); *(u32x2*)(hmb + off) = w;
        ss += (v[0] * v[0] + v[1] * v[1]) + (v[2] * v[2] + v[3] * v[3]); }
    ss = xor32_add(xor16_add(ss));
    if (fq == 0) sspm[fr * 16 + j] = ss;
}

__device__ __forceinline__ void meta_ffnup_unit(LAS unsigned char* lds, int j, const bf16_t* hmb, const bf16_t* wgu, const float* sspm, bf16_t* actm) {
    const int T = j >> 2, h = j & 3; const int rb[4] = {T * 256 + 32 * h, T * 256 + 32 * h + 16, T * 256 + 128 + 32 * h, T * 256 + 128 + 32 * h + 16};
    f32x4 acc[4];
    if (!skinny16(lds, hmb, wgu, D, rb, acc)) return;
    const int lane = threadIdx.x & 63, fr = lane & 15, fq = lane >> 4;
    const float rs = rstd_from_ssp(sspm, fr);
#pragma unroll
    for (int cb = 0; cb < 2; ++cb) { const f32x4 g = acc[cb] * rs, u = acc[cb + 2] * rs;
        u32x2 w; w.x = cvt_pk_bf16(silu_mul(g[0], u[0]), silu_mul(g[1], u[1])); w.y = cvt_pk_bf16(silu_mul(g[2], u[2]), silu_mul(g[3], u[3]));
        *(u32x2*)(actm + (size_t)fr * DFF + 32 * j + 16 * cb + 4 * fq) = w; }
}
__device__ __forceinline__ int crow(int r, int hi) { return (r & 3) + 8 * (r >> 2) + 4 * hi; }
typedef short v4i16_t __attribute__((ext_vector_type(4)));
__device__ __forceinline__ s16x4 vtr(const LAS unsigned char* p) { return __builtin_bit_cast(s16x4, __builtin_amdgcn_ds_read_tr16_b64_v4i16((LAS v4i16_t*)p)); }

__device__ __forceinline__ bf16_t* mix_row(bf16_t* mix, bf16_t* mixm, int b, int pp) {
    if (pp >= 128) return mix + ((size_t)b * SEQ + (pp - 128)) * D;
    if (pp >= PADP && b == 0) return mixm + (size_t)(pp - PADP) * D;
    return nullptr;
}

__device__ __forceinline__ void softmax_step(f32x16& s0, f32x16& s1, float& m_run, float& l_run, f32x16 (&o)[2], LAS float* wsf, int r32, int hi) {
    float mx = s0[0];
#pragma unroll
    for (int r = 1; r < 16; ++r) mx = fmaxf(mx, s0[r]);
#pragma unroll
    for (int r = 0; r < 16; ++r) mx = fmaxf(mx, s1[r]);
    mx = xor32_max(mx);
    const float mn = fmaxf(m_run, mx), f = __builtin_amdgcn_exp2f(m_run - mn);
    m_run = mn;
    float sum = 0.f;
#pragma unroll
    for (int r = 0; r < 16; ++r) { s0[r] = __builtin_amdgcn_exp2f(s0[r] - mn); s1[r] = __builtin_amdgcn_exp2f(s1[r] - mn); sum += s0[r] + s1[r]; }
    l_run = l_run * f + sum;
    if (hi == 0) wsf[r32] = f;
    LDS_WAIT();
#pragma unroll
    for (int r = 0; r < 16; ++r) { const float fo = wsf[crow(r, hi)]; o[0][r] *= fo; o[1][r] *= fo; }
    LDS_WAIT();
}
__device__ __forceinline__ float max3(float a, float b, float c) { float r; asm("v_max3_f32 %0, %1, %2, %3" : "=v"(r) : "v"(a), "v"(b), "v"(c)); return r; }
__device__ __forceinline__ bf16x8 ones_frag() { u32x4 w; asm volatile("v_mov_b32 %0, 0x3f803f80\n\tv_mov_b32 %1, 0x3f803f80\n\tv_mov_b32 %2, 0x3f803f80\n\tv_mov_b32 %3, 0x3f803f80" : "=v"(w.x), "=v"(w.y), "=v"(w.z), "=v"(w.w)); return __builtin_bit_cast(bf16x8, w); }
__device__ __forceinline__ void rowsum_step(f32x16& l, const bf16x8 (&pa)[4], const bf16x8& ones) {
#pragma unroll
    for (int s = 0; s < 4; ++s) l = __builtin_amdgcn_mfma_f32_32x32x16_bf16(pa[s], ones, l, 0, 0, 0);
}
__device__ __forceinline__ void pack_p(const f32x16& s0, const f32x16& s1, bf16x8 (&pa)[4]) {
#pragma unroll
    for (int s = 0; s < 4; ++s) { const f32x16& p = (s < 2) ? s0 : s1; const int b = 8 * (s & 1);
        u32x4 w; w.x = cvt_pk_bf16(p[b], p[b + 1]); w.y = cvt_pk_bf16(p[b + 2], p[b + 3]); w.z = cvt_pk_bf16(p[b + 4], p[b + 5]); w.w = cvt_pk_bf16(p[b + 6], p[b + 7]);
        pa[s] = __builtin_bit_cast(bf16x8, w); }
}
__device__ __forceinline__ void pv_step(f32x16 (&o)[2], const bf16x8 (&pa)[4], const LAS unsigned char* vbase, int half_stride, int lane) {
    const int hi = lane >> 5; const LAS unsigned char* vp = vbase + (4 * hi + ((lane & 15) >> 2)) * 64 + ((lane >> 4) & 1) * 32 + (lane & 3) * 8;
#pragma unroll
    for (int d0 = 0; d0 < 2; ++d0)
#pragma unroll
        for (int s = 0; s < 4; ++s) { const s16x4 lo = vtr(vp + d0 * half_stride + s * 1024), hh = vtr(vp + d0 * half_stride + s * 1024 + 512);
            const bf16x8 vf = (bf16x8){lo[0], lo[1], lo[2], lo[3], hh[0], hh[1], hh[2], hh[3]};
            o[d0] = __builtin_amdgcn_mfma_f32_32x32x16_bf16(pa[s], vf, o[d0], 0, 0, 0); }
}

__device__ __forceinline__ void v_frags_asm(bf16x8 (&vf)[2][4], const LAS unsigned char* vbase, int lane) {
    const int hi = lane >> 5; const unsigned vp = (unsigned)(size_t)(vbase + (4 * hi + ((lane & 15) >> 2)) * 64 + ((lane >> 4) & 1) * 32 + (lane & 3) * 8);
    u32x2 r[16];
    asm volatile(
        "ds_read_b64_tr_b16 %0, %16\n\tds_read_b64_tr_b16 %1, %16 offset:512\n\tds_read_b64_tr_b16 %2, %16 offset:1024\n\tds_read_b64_tr_b16 %3, %16 offset:1536\n\t"
        "ds_read_b64_tr_b16 %4, %16 offset:2048\n\tds_read_b64_tr_b16 %5, %16 offset:2560\n\tds_read_b64_tr_b16 %6, %16 offset:3072\n\tds_read_b64_tr_b16 %7, %16 offset:3584\n\t"
        "ds_read_b64_tr_b16 %8, %16 offset:4096\n\tds_read_b64_tr_b16 %9, %16 offset:4608\n\tds_read_b64_tr_b16 %10, %16 offset:5120\n\tds_read_b64_tr_b16 %11, %16 offset:5632\n\t"
        "ds_read_b64_tr_b16 %12, %16 offset:6144\n\tds_read_b64_tr_b16 %13, %16 offset:6656\n\tds_read_b64_tr_b16 %14, %16 offset:7168\n\tds_read_b64_tr_b16 %15, %16 offset:7680\n\t"
        "s_waitcnt lgkmcnt(0)"
        : "=&v"(r[0]), "=&v"(r[1]), "=&v"(r[2]), "=&v"(r[3]), "=&v"(r[4]), "=&v"(r[5]), "=&v"(r[6]), "=&v"(r[7]), "=&v"(r[8]), "=&v"(r[9]), "=&v"(r[10]), "=&v"(r[11]), "=&v"(r[12]), "=&v"(r[13]), "=&v"(r[14]), "=&v"(r[15])
        : "v"(vp) : "memory");
#pragma unroll
    for (int d0 = 0; d0 < 2; ++d0)
#pragma unroll
        for (int s = 0; s < 4; ++s) { const u32x2 lo = r[d0 * 8 + s * 2], hh = r[d0 * 8 + s * 2 + 1]; const u32x4 w = (u32x4){lo.x, lo.y, hh.x, hh.y}; vf[d0][s] = __builtin_bit_cast(bf16x8, w); }
}
__device__ __forceinline__ void v_frags(bf16x8 (&vf)[2][4], const LAS unsigned char* vbase, int half_stride, int lane) {
    const int hi = lane >> 5; const LAS unsigned char* vp = vbase + (4 * hi + ((lane & 15) >> 2)) * 64 + ((lane >> 4) & 1) * 32 + (lane & 3) * 8;
#pragma unroll
    for (int d0 = 0; d0 < 2; ++d0)
#pragma unroll
        for (int s = 0; s < 4; ++s) { const s16x4 lo = vtr(vp + d0 * half_stride + s * 1024), hh = vtr(vp + d0 * half_stride + s * 1024 + 512);
            vf[d0][s] = (bf16x8){lo[0], lo[1], lo[2], lo[3], hh[0], hh[1], hh[2], hh[3]}; }
}
__device__ __forceinline__ void pv_from(f32x16 (&o)[2], const bf16x8 (&pa)[4], const bf16x8 (&vf)[2][4]) {
#pragma unroll
    for (int d0 = 0; d0 < 2; ++d0)
#pragma unroll
        for (int s = 0; s < 4; ++s) o[d0] = __builtin_amdgcn_mfma_f32_32x32x16_bf16(pa[s], vf[d0][s], o[d0], 0, 0, 0);
}

constexpr int AL_V = 0, AL_K = 2 * 256 * 64, AL_LUT = AL_K + 256 * 144, AL_EXT = AL_LUT + 4 * 128 * 4, AL_WS = AL_EXT + 4 * 256 * 4, AL_ST = AL_WS + 8 * 256, AL_END = AL_ST + 8 * 4096;
__device__ __forceinline__ void attnA_unit(LAS unsigned char* lds, int b, int kvh, int ib, const bf16_t* Z, bf16_t* mix, bf16_t* mixm, const float* lutA, const float* sinks) {
    const int tid = threadIdx.x, lane = tid & 63, wid = __builtin_amdgcn_readfirstlane(tid >> 6), r32 = lane & 31, hi = lane >> 5;
    const int kp0 = 128 * (ib - 1);
    const bf16_t* Zb = Z + (size_t)b * LP * DIN;
#pragma unroll
    for (int it = 0; it < 4; ++it) { const int idx = tid + 512 * it, row = idx >> 3, ch = idx & 7, kpp = kp0 + row;
        u32x4 kv = (u32x4){0u, 0u, 0u, 0u}, vv = kv;
        if (kpp >= 0) { const bf16_t* src = Zb + (size_t)kpp * DIN + 64 * kvh + 8 * ch; kv = *(const u32x4*)(src + ZKA); vv = *(const u32x4*)(src + ZVA); }
        *(LAS u32x4*)(lds + AL_K + row * 144 + ch * 16) = kv;
        *(LAS u32x4*)(lds + AL_V + (ch >> 2) * (256 * 64) + row * 64 + (ch & 3) * 16) = vv; }
    ((LAS float*)(lds + AL_LUT))[tid] = lutA[(4 * kvh + (tid >> 7)) * 128 + (tid & 127)];
    const bool fast = ib >= 2;
    if (fast) {
#pragma unroll
        for (int it = 0; it < 2; ++it) { const int idx = tid + 512 * it, hh = idx >> 8, n = (idx & 255) - 64;
            ((LAS float*)(lds + AL_EXT))[idx] = ((unsigned)n < 128u) ? lutA[(4 * kvh + hh) * 128 + n] - sinks[4 * kvh + hh] * LOG2E : NEGF; }
    }
    __syncthreads();
    const int hl = wid >> 1, hq = 4 * kvh + hl;
    LAS float* wsf = (LAS float*)(lds + AL_WS) + wid * 64;
    const LAS float* lut = (const LAS float*)(lds + AL_LUT) + hl * 128;
    const LAS float* ext = (const LAS float*)(lds + AL_EXT) + hl * 256 + (133 + r32 - 4 * hi);
    const float sink2 = sinks[hq] * LOG2E;
#pragma unroll 1
    for (int sub = 0; sub < 2; ++sub) {
        const int qs = 128 * ib + 64 * (wid & 1) + 32 * sub, qpp = qs + r32;
        bf16x8 qr[4];
#pragma unroll
        for (int ks = 0; ks < 4; ++ks) qr[ks] = *(const bf16x8*)(Zb + (size_t)qpp * DIN + ZQA + 64 * hq + 16 * ks + 8 * hi);
        float m_run = NEGF, l_run = 0.f; f32x16 o[2]; o[0] = (f32x16){}; o[1] = (f32x16){};
        if (fast) {
            float m_off = 0.f;
#pragma unroll 1
            for (int jt = 0; jt < 3; ++jt) {
                const int kt = (wid & 1) + jt;
                const LAS float* ep = ext + (32 * sub - 64 * jt);
                f32x16 s0, s1;
#pragma unroll
                for (int r = 0; r < 16; ++r) { const int cr = (r & 3) + 8 * (r >> 2); s0[r] = ep[59 - cr]; s1[r] = ep[27 - cr]; }
                const LAS unsigned char* kb = lds + AL_K + (64 * kt + r32) * 144 + 16 * hi;
                bf16x8 kf0[4], kf1[4];
#pragma unroll
                for (int ks = 0; ks < 4; ++ks) { kf0[ks] = *(const LAS bf16x8*)(kb + ks * 32); kf1[ks] = *(const LAS bf16x8*)(kb + 32 * 144 + ks * 32); }
#pragma unroll
                for (int ks = 0; ks < 4; ++ks) { s0 = __builtin_amdgcn_mfma_f32_32x32x16_bf16(kf0[ks], qr[ks], s0, 0, 0, 0); s1 = __builtin_amdgcn_mfma_f32_32x32x16_bf16(kf1[ks], qr[ks], s1, 0, 0, 0); }
                bf16x8 vfa[2][4]; v_frags(vfa, lds + AL_V + (64 * kt) * 64, 256 * 64, lane);
                float mx = fmaxf(s0[0], s1[0]);
#pragma unroll
                for (int r = 1; r < 16; ++r) mx = fmaxf(mx, fmaxf(s0[r], s1[r]));
                mx = xor32_max(mx);
                if (__any(mx > m_off + 8.0f)) {
                    const float no = fmaxf(m_off, mx), f = __builtin_amdgcn_exp2f(m_off - no); m_off = no; l_run *= f;
                    if (hi == 0) wsf[r32] = f;
                    LDS_WAIT();
#pragma unroll
                    for (int r = 0; r < 16; ++r) { const float fo = wsf[crow(r, hi)]; o[0][r] *= fo; o[1][r] *= fo; }
                    LDS_WAIT();
                }
                if (__any(m_off != 0.f)) {
#pragma unroll
                    for (int r = 0; r < 16; ++r) { s0[r] -= m_off; s1[r] -= m_off; }
                }
                float sum = 0.f;
#pragma unroll
                for (int r = 0; r < 16; ++r) { s0[r] = __builtin_amdgcn_exp2f(s0[r]); s1[r] = __builtin_amdgcn_exp2f(s1[r]); sum += s0[r] + s1[r]; }
                l_run += sum;
                bf16x8 pa[4]; pack_p(s0, s1, pa);
                pv_from(o, pa, vfa);
            }
            m_run = sink2 + m_off;
        } else
#pragma unroll 1
        for (int jt = 0; jt < 3; ++jt) {
            const int kt = (wid & 1) + jt, kpp0 = kp0 + 64 * kt;
            f32x16 s0 = (f32x16){}, s1 = (f32x16){};
            const LAS unsigned char* kb = lds + AL_K + (64 * kt + r32) * 144 + 16 * hi;
#pragma unroll
            for (int ks = 0; ks < 4; ++ks) { const bf16x8 k0 = *(const LAS bf16x8*)(kb + ks * 32), k1 = *(const LAS bf16x8*)(kb + 32 * 144 + ks * 32);
                s0 = __builtin_amdgcn_mfma_f32_32x32x16_bf16(k0, qr[ks], s0, 0, 0, 0); s1 = __builtin_amdgcn_mfma_f32_32x32x16_bf16(k1, qr[ks], s1, 0, 0, 0); }
#pragma unroll
            for (int r = 0; r < 16; ++r) { const int kpp = kpp0 + crow(r, hi), n0 = qpp - kpp, n1 = n0 - 32;
                const bool v0 = ((unsigned)n0 < 128u) && (kpp >= PADP), v1 = ((unsigned)n1 < 128u) && (kpp + 32 >= PADP);
                s0[r] = v0 ? s0[r] + lut[n0 & 127] : NEGF; s1[r] = v1 ? s1[r] + lut[n1 & 127] : NEGF; }
            softmax_step(s0, s1, m_run, l_run, o, wsf, r32, hi);
            bf16x8 pa[4]; pack_p(s0, s1, pa);
            pv_step(o, pa, lds + AL_V + (64 * kt) * 64, 256 * 64, lane);
        }
        float lt = xor32_add(l_run); lt += __builtin_amdgcn_exp2f(sink2 - m_run);
        if (hi == 0) wsf[r32] = __builtin_amdgcn_rcpf(lt);
        LDS_WAIT();
#ifdef A_DIRECT_STORE
#pragma unroll
        for (int r = 0; r < 16; ++r) { const int q = crow(r, hi); const float inv = wsf[q]; bf16_t* orow = mix_row(mix, mixm, b, qs + q);
            if (orow) { orow[64 * hq + r32] = (bf16_t)(cvt_pk_bf16(o[0][r] * inv, 0.f) & 0xffffu); orow[64 * hq + 32 + r32] = (bf16_t)(cvt_pk_bf16(o[1][r] * inv, 0.f) & 0xffffu); } }
        LDS_WAIT();
#else
        LAS bf16_t* stg = (LAS bf16_t*)(lds + AL_ST) + wid * 2048;
#pragma unroll
        for (int r = 0; r < 16; ++r) { const int q = crow(r, hi); const float inv = wsf[q];
            stg[q * 64 + r32] = (bf16_t)(cvt_pk_bf16(o[0][r] * inv, 0.f) & 0xffffu); stg[q * 64 + 32 + r32] = (bf16_t)(cvt_pk_bf16(o[1][r] * inv, 0.f) & 0xffffu); }
        LDS_WAIT();
#pragma unroll
        for (int i = 0; i < 4; ++i) { const int row = i * 8 + (lane >> 3), ch = lane & 7; const u32x4 v = *(const LAS u32x4*)(stg + row * 64 + ch * 8);
            bf16_t* orow = mix_row(mix, mixm, b, qs + row); if (orow) *(u32x4*)(orow + 64 * hq + 8 * ch) = v; }
        LDS_WAIT();
#endif
    }
    __syncthreads();
}

constexpr int B2_RING = 0, B2_BT = 3 * 16384, B2_LUT = B2_BT + 7 * 4096, B2_WS = B2_LUT + 512, B2_X = B2_WS + 8 * 256, BL_END = B2_X + 4 * 32 * 68 * 4;
__device__ __forceinline__ void attnB_unit(LAS unsigned char* lds, int b, int h, int ib, const bf16_t* Z, bf16_t* mix, bf16_t* mixm, const float* lutB, const float* bt, bool chk, float lam, float one_m_lam_init, const float* gout) {
    const int tid = threadIdx.x, lane = tid & 63, wid = __builtin_amdgcn_readfirstlane(tid >> 6), r32 = lane & 31, hi = lane >> 5;
    const bf16_t* Zb = Z + (size_t)b * LP * DIN;
    const int KT_END = 2 * (ib + 1);
    const bf16x8 ones = ones_frag();
    const int c = wid >> 2, wq = wid & 3, qs = 128 * ib + 32 * wq, qpp = qs + r32;
#pragma unroll
    for (int i = 0; i < 4; ++i) { const int pc = wid + 8 * i; if (pc < 28) __builtin_amdgcn_global_load_lds((const unsigned*)(bt + h * 7168 + pc * 256 + lane * 4), (LAS unsigned*)(lds + B2_BT + pc * 1024), 16, 0, 0); }
    const bf16_t* ksrc = Zb + (size_t)lane * DIN + ZKB + 64 * h + 8 * wid;
    const bf16_t* vsrc = Zb + (size_t)(16 * (wid & 3) + (lane >> 2)) * DIN + ZVB + 64 * h + 32 * (wid >> 2) + 8 * (lane & 3);
#define B_DMA(t, slot) do { __builtin_amdgcn_global_load_lds((const unsigned*)(ksrc + (size_t)(64 * (t)) * DIN), (LAS unsigned*)(lds + B2_RING + (slot) * 16384 + wid * 1024), 16, 0, 0); \
                            __builtin_amdgcn_global_load_lds((const unsigned*)(vsrc + (size_t)(64 * (t)) * DIN), (LAS unsigned*)(lds + B2_RING + (slot) * 16384 + 8192 + wid * 1024), 16, 0, 0); } while (0)
    B_DMA(1, 0);
    if (2 < KT_END) B_DMA(2, 1);
    bf16x8 qr[2];
#pragma unroll
    for (int ks = 0; ks < 2; ++ks) qr[ks] = *(const bf16x8*)(Zb + (size_t)qpp * DIN + ZQB + 64 * h + 32 * c + 16 * ks + 8 * hi);
    const float* lg = lutB + h * 128;
    const float cfar = lg[127];
    if (tid < 128) ((LAS float*)(lds + B2_LUT))[tid] = lg[tid];
    LAS float* wsf = (LAS float*)(lds + B2_WS) + wid * 64;
    const LAS float* lut = (const LAS float*)(lds + B2_LUT);
    float mref = 0.f; f32x16 o[2], lsum; o[0] = (f32x16){}; o[1] = (f32x16){}; lsum = (f32x16){};
    f32x16 negm;
#pragma unroll
    for (int r = 0; r < 16; ++r) negm[r] = cfar;
    int slot = 0;
    for (int t = 1; t < KT_END; ++t) {
        if (t + 1 < KT_END) asm volatile("s_waitcnt vmcnt(2)" ::: "memory"); else asm volatile("s_waitcnt vmcnt(0)" ::: "memory");
        asm volatile("s_waitcnt lgkmcnt(0)" ::: "memory");
        __builtin_amdgcn_s_barrier();
        asm volatile("" ::: "memory");
        const int kpp0 = 64 * t;
        const bool late_dma = (t == 1) && (kpp0 <= qs + 31);
        if (!late_dma && t + 2 < KT_END) { const int s2 = slot == 0 ? 2 : slot - 1; B_DMA(t + 2, s2); }
        if (kpp0 <= qs + 31) {
            const LAS unsigned char* kb = lds + B2_RING + slot * 16384 + (4 * c + hi) * 1024 + r32 * 16;
            const bf16x8 k00 = *(const LAS bf16x8*)(kb), k01 = *(const LAS bf16x8*)(kb + 2048), k10 = *(const LAS bf16x8*)(kb + 512), k11 = *(const LAS bf16x8*)(kb + 2048 + 512);
            f32x16 s0, s1; bool resc = false; float delta = 0.f;
            bf16x8 vfr[2][4];
            if (t == 1) {
                s0 = (f32x16){}; s1 = (f32x16){};
                s0 = __builtin_amdgcn_mfma_f32_32x32x16_bf16(k00, qr[0], s0, 0, 0, 0); s1 = __builtin_amdgcn_mfma_f32_32x32x16_bf16(k10, qr[0], s1, 0, 0, 0);
                s0 = __builtin_amdgcn_mfma_f32_32x32x16_bf16(k01, qr[1], s0, 0, 0, 0); s1 = __builtin_amdgcn_mfma_f32_32x32x16_bf16(k11, qr[1], s1, 0, 0, 0);
                v_frags_asm(vfr, lds + B2_RING + slot * 16384 + 8192, lane); asm volatile("" :: "v"(k00), "v"(k01), "v"(k10), "v"(k11));
                float mx = NEGF;
#pragma unroll
                for (int r = 0; r < 16; ++r) { const int kpp = kpp0 + crow(r, hi), n0 = qpp - kpp, n1 = n0 - 32;
                    const bool v0 = (n0 >= 0) && (kpp >= PADP), v1 = (n1 >= 0) && (kpp + 32 >= PADP);
                    s0[r] = v0 ? s0[r] + lut[n0 > 127 ? 127 : (n0 & 127)] : NEGF; s1[r] = v1 ? s1[r] + lut[n1 > 127 ? 127 : (n1 & 127)] : NEGF; mx = fmaxf(mx, fmaxf(s0[r], s1[r])); }
                asm volatile("" ::: "memory");
                if (t + 2 < KT_END) { const int s2 = slot == 0 ? 2 : slot - 1; B_DMA(t + 2, s2); }
                mx = xor32_max(mx);
                mref = mx;
#pragma unroll
                for (int r = 0; r < 16; ++r) { s0[r] -= mx; s1[r] -= mx; negm[r] = cfar - mx; }
            } else {
                const int d0 = qs - kpp0;
                if (d0 >= 192) {
                    s0 = __builtin_amdgcn_mfma_f32_32x32x16_bf16(k00, qr[0], negm, 0, 0, 0); s1 = __builtin_amdgcn_mfma_f32_32x32x16_bf16(k10, qr[0], negm, 0, 0, 0);
                    s0 = __builtin_amdgcn_mfma_f32_32x32x16_bf16(k01, qr[1], s0, 0, 0, 0); s1 = __builtin_amdgcn_mfma_f32_32x32x16_bf16(k11, qr[1], s1, 0, 0, 0);
                    v_frags_asm(vfr, lds + B2_RING + slot * 16384 + 8192, lane); asm volatile("" :: "v"(k00), "v"(k01), "v"(k10), "v"(k11));
                } else {
                    const int j0 = (d0 >> 5) + 1, j1 = j0 - 1;
                    const LAS f32x4* t0 = (const LAS f32x4*)(lds + B2_BT) + j0 * 256 + lane; const LAS f32x4* t1 = (const LAS f32x4*)(lds + B2_BT) + j1 * 256 + lane;
#pragma unroll
                    for (int g = 0; g < 4; ++g) { const f32x4 a = t0[g * 64], bq = t1[g * 64]; s0[4 * g] = a[0]; s0[4 * g + 1] = a[1]; s0[4 * g + 2] = a[2]; s0[4 * g + 3] = a[3]; s1[4 * g] = bq[0]; s1[4 * g + 1] = bq[1]; s1[4 * g + 2] = bq[2]; s1[4 * g + 3] = bq[3]; }
                    s0 = __builtin_amdgcn_mfma_f32_32x32x16_bf16(k00, qr[0], s0, 0, 0, 0); s1 = __builtin_amdgcn_mfma_f32_32x32x16_bf16(k10, qr[0], s1, 0, 0, 0);
                    s0 = __builtin_amdgcn_mfma_f32_32x32x16_bf16(k01, qr[1], s0, 0, 0, 0); s1 = __builtin_amdgcn_mfma_f32_32x32x16_bf16(k11, qr[1], s1, 0, 0, 0);
                    v_frags_asm(vfr, lds + B2_RING + slot * 16384 + 8192, lane); asm volatile("" :: "v"(k00), "v"(k01), "v"(k10), "v"(k11));
#pragma unroll
                    for (int r = 0; r < 16; ++r) { s0[r] -= mref; s1[r] -= mref; }
                }
                if (chk) {
                    float mx = fmaxf(s0[0], s1[0]);
#pragma unroll
                    for (int r = 1; r < 16; ++r) mx = max3(mx, s0[r], s1[r]);
                    mx = xor32_max(mx);
                    if (__any(mx > 8.0f)) {
                        delta = fmaxf(mx, 0.f); mref += delta; resc = true;
#pragma unroll
                        for (int r = 0; r < 16; ++r) { s0[r] -= delta; s1[r] -= delta; negm[r] = cfar - mref; }
                    }
                }
            }
#pragma unroll
            for (int r = 0; r < 16; ++r) { s0[r] = __builtin_amdgcn_exp2f(s0[r]); s1[r] = __builtin_amdgcn_exp2f(s1[r]); }
            if (resc) {
                const float f = __builtin_amdgcn_exp2f(-delta);
                if (hi == 0) wsf[r32] = f;
                LDS_WAIT();
#pragma unroll
                for (int r = 0; r < 16; ++r) { const float fo = wsf[crow(r, hi)]; o[0][r] *= fo; o[1][r] *= fo; lsum[r] *= fo; }
                LDS_WAIT();
            }
            bf16x8 pa[4]; pack_p(s0, s1, pa);
            rowsum_step(lsum, pa, ones);
            pv_from(o, pa, vfr);
        }
        slot = slot == 2 ? 0 : slot + 1;
    }
#undef B_DMA
    LAS float* X = (LAS float*)(lds + B2_X) + wq * (32 * 68);
#pragma unroll
    for (int r = 0; r < 16; ++r) { const float inv = __builtin_amdgcn_rcpf(lsum[r]); o[0][r] *= inv; o[1][r] *= inv; }
    if (c == 1) {
#pragma unroll
        for (int r = 0; r < 16; ++r) { const int q = crow(r, hi); X[q * 68 + r32] = o[0][r]; X[q * 68 + 32 + r32] = o[1][r]; }
    }
    __syncthreads();
    if (c == 0) {
#pragma unroll
        for (int r = 0; r < 16; ++r) { const int q = crow(r, hi); X[q * 68 + r32] = o[0][r] - lam * X[q * 68 + r32]; X[q * 68 + 32 + r32] = o[1][r] - lam * X[q * 68 + 32 + r32]; }
        LDS_WAIT();
        const int q = lane >> 1, hf = lane & 1; f32x4 v[8]; float ss = 0.f;
#pragma unroll
        for (int i = 0; i < 8; ++i) { v[i] = *(const LAS f32x4*)(X + q * 68 + 32 * hf + 4 * i); ss += (v[i][0] * v[i][0] + v[i][1] * v[i][1]) + (v[i][2] * v[i][2] + v[i][3] * v[i][3]); }
        ss += __shfl_xor(ss, 1);
        const float rs = __builtin_amdgcn_rsqf(ss * (1.0f / 64.0f) + EPS) * one_m_lam_init;
        bf16_t* orow = mix_row(mix, mixm, b, qs + q);
#pragma unroll
        for (int i = 0; i < 4; ++i) { const f32x4 g0 = *(const f32x4*)(gout + 32 * hf + 8 * i), g1 = *(const f32x4*)(gout + 32 * hf + 8 * i + 4); const f32x4 a = v[2 * i] * g0 * rs, d = v[2 * i + 1] * g1 * rs;
            u32x4 w; w.x = cvt_pk_bf16(a[0], a[1]); w.y = cvt_pk_bf16(a[2], a[3]); w.z = cvt_pk_bf16(d[0], d[1]); w.w = cvt_pk_bf16(d[2], d[3]);
            if (orow) *(u32x4*)(orow + 512 + 64 * h + 32 * hf + 8 * i) = w; }
    }
    __syncthreads();
}

constexpr int CL_U = 0, CL_D = 80 * 528, CL_END = CL_D + 64 * 528;
__device__ __forceinline__ void pool_unit(LAS unsigned char* lds, int b, int jb, const bf16_t* Z, bf16_t* mix, bf16_t* mixm, const bf16_t* wpt, const float* pscale) {
    const int tid = threadIdx.x, lane = tid & 63, wid = __builtin_amdgcn_readfirstlane(tid >> 6), r32 = lane & 31, hi = lane >> 5;
    const bf16_t* Zb = Z + (size_t)b * LP * DIN;
    const int pp0 = 64 * jb;
    const int g = wid >> 1, rh = wid & 1;
    bf16x8 afr[4][2]; f32x4 scv[2][4];
#pragma unroll
    for (int ks = 0; ks < 4; ++ks)
#pragma unroll
        for (int dh = 0; dh < 2; ++dh) afr[ks][dh] = *(const bf16x8*)(wpt + ((size_t)g * 64 + 32 * dh + r32) * 64 + 16 * ks + 8 * hi);
#pragma unroll
    for (int dh = 0; dh < 2; ++dh)
#pragma unroll
        for (int rq = 0; rq < 4; ++rq) scv[dh][rq] = *(const f32x4*)(pscale + 64 * g + 32 * dh + 8 * rq + 4 * hi);
#pragma unroll
    for (int it = 0; it < 5; ++it) { const int idx = tid + 512 * it, row = idx >> 5, ch = idx & 31;
        *(LAS u32x4*)(lds + CL_U + row * 528 + ch * 16) = *(const u32x4*)(Zb + (size_t)(pp0 - 16 + row) * DIN + ZUC + 8 * ch); }
    __syncthreads();
    { const int t = tid >> 3, pos = pp0 + t - PADP;
#pragma unroll
      for (int cc = 0; cc < 4; ++cc) { const int ch = (tid & 7) * 4 + cc, g = ch >> 3, w = 2 << g; int cnt = pos + 1 < w ? pos + 1 : w; cnt = cnt < 1 ? 1 : cnt;
          float acc[8];
#pragma unroll
          for (int e = 0; e < 8; ++e) acc[e] = 0.f;
          u32x4 x0 = (u32x4){0u, 0u, 0u, 0u};
          for (int j = 0; j < cnt; ++j) { const u32x4 x = *(const LAS u32x4*)(lds + CL_U + (16 + t - j) * 528 + ch * 16); if (j == 0) x0 = x;
              acc[0] += bf16_lo(x.x); acc[1] += bf16_hi(x.x); acc[2] += bf16_lo(x.y); acc[3] += bf16_hi(x.y); acc[4] += bf16_lo(x.z); acc[5] += bf16_hi(x.z); acc[6] += bf16_lo(x.w); acc[7] += bf16_hi(x.w); }
          const float ic = 1.0f / (float)cnt;
          u32x4 d; d.x = cvt_pk_bf16(acc[0] * ic - bf16_lo(x0.x), acc[1] * ic - bf16_hi(x0.x)); d.y = cvt_pk_bf16(acc[2] * ic - bf16_lo(x0.y), acc[3] * ic - bf16_hi(x0.y));
          d.z = cvt_pk_bf16(acc[4] * ic - bf16_lo(x0.z), acc[5] * ic - bf16_hi(x0.z)); d.w = cvt_pk_bf16(acc[6] * ic - bf16_lo(x0.w), acc[7] * ic - bf16_hi(x0.w));
          *(LAS u32x4*)(lds + CL_D + t * 528 + ch * 16) = d; } }
    __syncthreads();
    f32x16 acc[2]; acc[0] = (f32x16){}; acc[1] = (f32x16){};
#pragma unroll
    for (int ks = 0; ks < 4; ++ks) { const bf16x8 bfrag = *(const LAS bf16x8*)(lds + CL_D + (32 * rh + r32) * 528 + (64 * g + 16 * ks + 8 * hi) * 2);
#pragma unroll
        for (int dh = 0; dh < 2; ++dh) acc[dh] = __builtin_amdgcn_mfma_f32_32x32x16_bf16(afr[ks][dh], bfrag, acc[dh], 0, 0, 0); }
    bf16_t* orow = mix_row(mix, mixm, b, pp0 + 32 * rh + r32);
    if (orow) {
#pragma unroll
        for (int dh = 0; dh < 2; ++dh)
#pragma unroll
            for (int rq = 0; rq < 4; ++rq) { const int dd = 32 * dh + 8 * rq + 4 * hi; const f32x4 sc = scv[dh][rq];
                u32x2 w; w.x = cvt_pk_bf16(acc[dh][4 * rq] * sc[0], acc[dh][4 * rq + 1] * sc[1]); w.y = cvt_pk_bf16(acc[dh][4 * rq + 2] * sc[2], acc[dh][4 * rq + 3] * sc[3]);
                *(u32x2*)(orow + 768 + 64 * g + dd) = w; }
    }
    __syncthreads();
}
__device__ __forceinline__ void cvt_item(const float* s0, const float* s1, int ld, bf16_t* dst, int K, const float* gk, LAS unsigned* scr, int lane) {
    const int c = lane & 15, q = lane >> 4;
    const float* src = ((c >> 3) ? s1 : s0) + 4 * (c & 7);
    f32x4 a[8], b[8];
#pragma unroll
    for (int jj = 0; jj < 8; ++jj) { const int k = 8 * jj + 2 * q; a[jj] = *(const f32x4*)(src + (size_t)k * ld); b[jj] = *(const f32x4*)(src + (size_t)(k + 1) * ld); }
#pragma unroll
    for (int jj = 0; jj < 8; ++jj) { const int k = 8 * jj + 2 * q; float g0 = 1.f, g1 = 1.f; if (gk) { g0 = gk[k]; g1 = gk[k + 1]; }
#pragma unroll
        for (int e = 0; e < 4; ++e) scr[(4 * c + e) * 33 + 4 * jj + q] = cvt_pk_bf16(a[jj][e] * g0, b[jj][e] * g1); }
    LDS_WAIT(); asm volatile("" ::: "memory");
#pragma unroll
    for (int p = 0; p < 8; ++p) { const int n = p * 8 + (lane >> 3), ch = lane & 7; const LAS unsigned* s = scr + n * 33 + 4 * ch;
        u32x4 o; o.x = s[0]; o.y = s[1]; o.z = s[2]; o.w = s[3];
        *(u32x4*)(dst + (size_t)n * K + 8 * ch) = o; }
    LDS_WAIT(); asm volatile("" ::: "memory");
}

__device__ __forceinline__ void cvt_item8(const float* s0, const float* s1, int ld, unsigned char* dst, int KB, const float* gk, float sc, LAS unsigned* scr, int lane) {
    const int c = lane & 15, q = lane >> 4;
    const float* src = ((c >> 3) ? s1 : s0) + 4 * (c & 7);
    f32x4 v[4][4];
#pragma unroll
    for (int jj = 0; jj < 4; ++jj)
#pragma unroll
        for (int i = 0; i < 4; ++i) v[jj][i] = *(const f32x4*)(src + (size_t)(16 * jj + 4 * q + i) * ld);
#pragma unroll
    for (int jj = 0; jj < 4; ++jj) { float g[4];
#pragma unroll
        for (int i = 0; i < 4; ++i) g[i] = (gk ? gk[16 * jj + 4 * q + i] : 1.0f) * sc;
#pragma unroll
        for (int e = 0; e < 4; ++e) scr[(4 * c + e) * 17 + 4 * jj + q] = pack4_fp8(v[jj][0][e] * g[0], v[jj][1][e] * g[1], v[jj][2][e] * g[2], v[jj][3][e] * g[3]); }
    LDS_WAIT(); asm volatile("" ::: "memory");
#pragma unroll
    for (int p = 0; p < 4; ++p) { const int n = p * 16 + (lane >> 2), ch = lane & 3; const LAS unsigned* s = scr + n * 17 + 4 * ch;
        u32x4 o; o.x = s[0]; o.y = s[1]; o.z = s[2]; o.w = s[3];
        *(u32x4*)(dst + (size_t)n * KB + 16 * ch) = o; }
    LDS_WAIT(); asm volatile("" ::: "memory");
}

struct ProArgs {
    const float *x, *meta, *relb, *g_mix, *w_in, *gain_a, *gain_b, *dlam, *w_pool, *w_out, *g_ffn, *wg, *wu, *wd, *w_router, *weg, *weu, *wed;
    unsigned char* ws;
};
constexpr int IT_WIN = 2 * 16 * 28, IT_WOUT = 2 * 16 * 16, IT_WGU = 16 * 88, IT_WD = 44 * 16, IT_WEGU = 8 * 16 * 112, IT_WED = 8 * 56 * 16;
constexpr int IT_TOTAL = IT_WIN + IT_WOUT + IT_WGU + IT_WD + IT_WEGU + IT_WED;
constexpr size_t MS_GT = MS_END;
constexpr size_t MS_LAM = MS_GT + 2 * 4 * 64 * 4;
constexpr size_t MS_BT = MS_LAM + 256;
constexpr size_t MS_BCHK = MS_BT + 4 * 7 * 4096;
constexpr size_t MS_WRB = MS_BCHK + 256;
static_assert(MS_WRB + 16 * 1024 * 2 <= 10 * MiB, "misc map");

__device__ __forceinline__ void convert_item(const ProArgs& P, int it, LAS unsigned* scr, int lane) {
    unsigned char* ws = P.ws;
    if (it < IT_WIN) { const int l = it / (16 * 28), r = it % (16 * 28), kb = r / 28, nb = r % 28, T = nb >> 2, blk = nb & 3, c = blk >> 1, hp = blk & 1;
        const float* W = P.w_in + (size_t)l * D * DIN + (size_t)(64 * kb) * DIN + 256 * T + 32 * c;
        cvt_item(W + 64 * (2 * hp), W + 64 * (2 * hp + 1), DIN, (bf16_t*)(ws + WS_WIN) + ((size_t)l * DIN + 64 * nb) * D + 64 * kb, D, P.g_mix + l * D + 64 * kb, scr, lane); return; }
    it -= IT_WIN;
    if (it < IT_WOUT) { const int l = it / 256, r = it % 256, kb = r / 16, nb = r % 16;
        const float* W = P.w_out + (size_t)l * D * D + (size_t)(64 * kb) * D + 64 * nb;
        cvt_item(W, W + 32, D, (bf16_t*)(ws + WS_WOUT) + ((size_t)l * D + 64 * nb) * D + 64 * kb, D, nullptr, scr, lane); return; }
    it -= IT_WOUT;
    if (it < IT_WGU) { const int kb = it / 88, nb = it % 88, T = nb >> 2, blk = nb & 3;
        const float* W = ((blk < 2) ? P.wg : P.wu) + (size_t)(64 * kb) * DFF + 128 * T + 64 * (blk & 1);
        cvt_item(W, W + 32, DFF, (bf16_t*)(ws + WS_WGU) + ((size_t)64 * nb) * D + 64 * kb, D, P.g_ffn + 64 * kb, scr, lane); return; }
    it -= IT_WGU;
    if (it < IT_WD) { const int kb = it / 16, nb = it % 16;
        const float* W = P.wd + (size_t)(64 * kb) * D + 64 * nb;
        cvt_item(W, W + 32, D, (bf16_t*)(ws + WS_WD) + ((size_t)64 * nb) * DFF + 64 * kb, DFF, nullptr, scr, lane); return; }
    it -= IT_WD;
    if (it < IT_WEGU) { const int e = it / (16 * 112), r = it % (16 * 112), kb = r / 112, nb = r % 112, T = nb >> 2, blk = nb & 3;
        const float* W = ((blk < 2) ? P.weg : P.weu) + (size_t)e * D * DFE + (size_t)(64 * kb) * DFE + 128 * T + 64 * (blk & 1);
        cvt_item8(W, W + 32, DFE, ws + WS_WEGU + ((size_t)e * 2 * DFE + 64 * nb) * D + 64 * kb, D, P.g_ffn + D + 64 * kb, (float)(1 << WEGU_SH), scr, lane); return; }
    it -= IT_WEGU;
    { const int e = it / (56 * 16), r = it % (56 * 16), kb = r / 16, nb = r % 16;
        const float* W = P.wed + (size_t)e * DFE * D + (size_t)(64 * kb) * D + 64 * nb;
        cvt_item8(W, W + 32, D, ws + WS_WED + ((size_t)e * D + 64 * nb) * DFE + 64 * kb, DFE, nullptr, (float)(1 << WED_SH), scr, lane); }
}

__device__ __forceinline__ void row_setup(const float* xrow, bf16_t* hb, float* ssp, float* fcopy, int lane, int nssp4) {
    const f32x4* xr = (const f32x4*)xrow + lane; f32x4 v[4]; float s = 0.f;
#pragma unroll
    for (int j = 0; j < 4; ++j) { v[j] = xr[64 * j]; s += (v[j][0] * v[j][0] + v[j][1] * v[j][1]) + (v[j][2] * v[j][2] + v[j][3] * v[j][3]); }
    s = wave_sum(s);
#pragma unroll
    for (int j = 0; j < 4; ++j) { u32x2 w; w.x = cvt_pk_bf16(v[j][0], v[j][1]); w.y = cvt_pk_bf16(v[j][2], v[j][3]); *((u32x2*)hb + lane + 64 * j) = w; if (fcopy) *((f32x4*)fcopy + lane + 64 * j) = v[j]; }
    if (lane < nssp4) *((f32x4*)ssp + lane) = (f32x4){lane == 0 ? s : 0.f, 0.f, 0.f, 0.f};
}

__device__ __forceinline__ int t5_bucket(int n) {
    if (n < 16) return n;
    const int v = 16 + (int)(__logf((float)n * (1.0f / 16.0f)) / 2.0794415416798357f * 16.0f);
    return v < 31 ? v : 31;
}

__device__ __forceinline__ void prologue(const ProArgs& P, LAS unsigned char* lds, int vcu, int G) {
    const int tid = threadIdx.x, lane = tid & 63, wave = __builtin_amdgcn_readfirstlane(tid >> 6);
    unsigned char* ws = P.ws; unsigned char* ms = ws + WS_MISC;
    const int gw = vcu * NWAVES + wave, NGW = G * NWAVES, gt_ = vcu * NTHREADS + tid, NGT = G * NTHREADS;
    for (int m = gw; m < M; m += NGW) row_setup(P.x + (size_t)m * D, (bf16_t*)(ws + WS_HB) + (size_t)m * D, (float*)(ms + MS_SSP) + (size_t)m * 4, nullptr, lane, 1);
    if (gw < NMETA) row_setup(P.meta + (size_t)gw * D, (bf16_t*)(ms + MS_HMB) + (size_t)gw * D, (float*)(ms + MS_SSPM) + gw * 16, (float*)(ms + MS_HM) + (size_t)gw * D, lane, 4);
    for (int i = gt_; i < 12 * 128; i += NGT) { const int h = i >> 7, n = i & 127; const float v = P.relb[t5_bucket(n) * 12 + h] * LOG2E;
        if (h < 8) ((float*)(ms + MS_LUTA))[h * 128 + n] = v; else ((float*)(ms + MS_LUTB))[(h - 8) * 128 + n] = v; }
    for (int i = gt_; i < 2 * 4 * 64; i += NGT) { const int l = i >> 8, t = (i >> 6) & 3, j = i & 63; float v = 0.f;
        if (t == 0) v = P.gain_a[(l * 2 + 0) * 64 + j] * 0.125f * LOG2E; else if (t == 1) v = P.gain_a[(l * 2 + 1) * 64 + j];
        else if (t == 2) { if (j < 32) v = P.gain_b[(l * 2 + 0) * 32 + j] * 0.17677669529663687f * LOG2E; } else { if (j < 32) v = P.gain_b[(l * 2 + 1) * 32 + j]; }
        ((float*)(ms + MS_GT))[i] = v; }
    if (gt_ < 2) { const int l = gt_; const float* dl = P.dlam + l * 128; float s1 = 0.f, s2 = 0.f;
        for (int j = 0; j < 32; ++j) { s1 += dl[j] * dl[32 + j]; s2 += dl[64 + j] * dl[96 + j]; }
        ((float*)(ms + MS_LAM))[l] = __expf(s1) - __expf(s2) + (0.8f - 0.6f * __expf(-0.3f * (float)l)); }
    for (int i = gt_; i < 2 * 4 * 64 * 64; i += NGT) { const int c = i & 63, dd = (i >> 6) & 63, lg = i >> 12;
        const float v = P.w_pool[((size_t)lg * 64 + c) * 64 + dd]; ((bf16_t*)(ms + MS_WPT))[i] = (bf16_t)(cvt_pk_bf16(v, 0.f) & 0xffffu); }
    for (int i = gt_; i < 1024 * 8; i += NGT) { const float wv = P.w_router[i] * P.g_ffn[D + (i >> 3)]; ((float*)(ms + MS_WR))[i] = wv;
        const int k = i >> 3, e = i & 7; const unsigned hi = cvt_pk_bf16(wv, 0.f) & 0xffffu; const unsigned lo = cvt_pk_bf16(wv - __uint_as_float(hi << 16), 0.f) & 0xffffu;
        ((bf16_t*)(ms + MS_WRB))[e * 1024 + k] = (bf16_t)hi; ((bf16_t*)(ms + MS_WRB))[(8 + e) * 1024 + k] = (bf16_t)lo; }
    if (gw < 8) { const int l = gw >> 2, h = gw & 3, j = lane & 31;
        float gq = fabsf(P.gain_b[(l * 2 + 0) * 32 + j]) * 0.17677669529663687f * LOG2E, gk = fabsf(P.gain_b[(l * 2 + 1) * 32 + j]);
        const float b0 = P.relb[t5_bucket(lane) * 12 + 8 + h] * LOG2E, b1 = P.relb[t5_bucket(lane + 64) * 12 + 8 + h] * LOG2E; float bmax = fmaxf(b0, b1), bmin = fminf(b0, b1);
#pragma unroll
        for (int o = 1; o < 64; o <<= 1) { gq = fmaxf(gq, __shfl_xor(gq, o)); gk = fmaxf(gk, __shfl_xor(gk, o)); bmax = fmaxf(bmax, __shfl_xor(bmax, o)); bmin = fminf(bmin, __shfl_xor(bmin, o)); }
        const float bound = 64.0f * 1.02f * gq * gk + (bmax - bmin);
        if (lane == 0) ((int*)(ms + MS_BCHK))[gw] = (bound < 96.0f) ? 0 : 1; }
    for (int i = gt_; i < 4 * 7 * 1024; i += NGT) { const int h = i / 7168, rem = i - h * 7168, j = rem >> 10, e = rem & 1023, ln = e >> 4, r = e & 15; const int n = 32 * (j - 1) + (ln & 31) - ((r & 3) + 8 * (r >> 2) + 4 * (ln >> 5));
        ((float*)(ms + MS_BT))[h * 7168 + j * 1024 + (r >> 2) * 256 + ln * 4 + (r & 3)] = n < 0 ? NEGF : P.relb[t5_bucket(n > 127 ? 127 : n) * 12 + 8 + h] * LOG2E; }
    { const int per = PADP * DIN * 2 / 16; for (int i = gt_; i < NBATCH * per; i += NGT) { const int b = i / per, r = i % per; *((u32x4*)(ws + WS_Z + (size_t)b * LP * DIN * 2) + r) = (u32x4){0u, 0u, 0u, 0u}; } }
    LAS unsigned* scr = (LAS unsigned*)lds + wave * (64 * 33);
    for (int it = gw; it < IT_TOTAL; it += NGW) convert_item(P, it, scr, lane);
}

__device__ __forceinline__ void router_phase(LAS unsigned char* lds, const bf16_t* hres, const bf16_t* wrb, const float* ssp4, float* lrs, int* ltok, float* lgate, unsigned* cnt, int vcu, int G) {
    const int tid = threadIdx.x, lane = tid & 63, wave = __builtin_amdgcn_readfirstlane(tid >> 6);
    LAS int* e0s = (LAS int*)lds; LAS int* e1s = e0s + 128; LAS float* g0s = (LAS float*)(e1s + 128); LAS float* g1s = g0s + 128;
    LAS unsigned* lcnt = (LAS unsigned*)(g1s + 128); LAS unsigned* lbase = lcnt + 16; LAS unsigned* rk0 = lbase + 16; LAS unsigned* rk1 = rk0 + 128; LAS float* rss = (LAS float*)(rk1 + 128);
    for (int chunk = vcu; chunk < M / 128; chunk += G) {
        if (tid < 16) lcnt[tid] = 0u;
        {
            const int tok0 = chunk * 128 + wave * 16;
            const bf16_t* hb = hres + (size_t)(tok0 + (lane & 15)) * D + 8 * (lane >> 4);
            const bf16_t* wb = wrb + (size_t)(lane & 15) * D + 8 * (lane >> 4);
            f32x4 acc = (f32x4){0.f, 0.f, 0.f, 0.f};
#pragma unroll 8
            for (int k0 = 0; k0 < D; k0 += 32) acc = __builtin_amdgcn_mfma_f32_16x16x32_bf16(*(const bf16x8*)(wb + k0), *(const bf16x8*)(hb + k0), acc, 0, 0, 0);
            float lg[8];
#pragma unroll
            for (int i = 0; i < 4; ++i) { const float s = xor32_add(acc[i]);
                const auto r = __builtin_amdgcn_permlane16_swap(__float_as_uint(s), __float_as_uint(s), false, false); lg[i] = __uint_as_float(r[0]); lg[4 + i] = __uint_as_float(r[1]); }
            if (lane < 16) {
                const f32x4 q4 = *(const f32x4*)(ssp4 + (size_t)(tok0 + lane) * 4);
                const float rs = __builtin_amdgcn_rsqf(((q4[0] + q4[1]) + (q4[2] + q4[3])) * (1.0f / D) + EPS);
                int b0 = 0; float v0 = lg[0] * rs;
#pragma unroll
                for (int e = 1; e < 8; ++e) { const float v = lg[e] * rs; if (v > v0) { v0 = v; b0 = e; } }
                int b1 = -1; float v1 = 0.f;
#pragma unroll
                for (int e = 0; e < 8; ++e) { const float v = lg[e] * rs; if (e != b0 && (b1 < 0 || v > v1)) { v1 = v; b1 = e; } }
                const float ex = __expf(v1 - v0), gg0 = 1.0f / (1.0f + ex), gg1 = ex * gg0;
                const int s = wave * 16 + lane; e0s[s] = b0; e1s[s] = b1; g0s[s] = gg0; g1s[s] = gg1; rss[s] = rs;
            }
        }
        __syncthreads();
        if (tid < 128) { rk0[tid] = __hip_atomic_fetch_add(&lcnt[e0s[tid]], 1u, __ATOMIC_RELAXED, __HIP_MEMORY_SCOPE_WORKGROUP); rk1[tid] = __hip_atomic_fetch_add(&lcnt[8 + e1s[tid]], 1u, __ATOMIC_RELAXED, __HIP_MEMORY_SCOPE_WORKGROUP); }
        __syncthreads();
        if (tid < 16) lbase[tid] = __hip_atomic_fetch_add(cnt + 64 * tid, lcnt[tid], __ATOMIC_RELAXED, __HIP_MEMORY_SCOPE_AGENT);
        __syncthreads();
        if (tid < 128) { const int tok = chunk * 128 + tid; const int ga = e0s[tid], gb = 8 + e1s[tid];
            const unsigned sa = lbase[ga] + rk0[tid], sb = lbase[gb] + rk1[tid];
            ltok[(size_t)ga * LCAP + sa] = tok; lgate[(size_t)ga * LCAP + sa] = g0s[tid]; lrs[(size_t)ga * LCAP + sa] = rss[tid]; ltok[(size_t)gb * LCAP + sb] = tok; lgate[(size_t)gb * LCAP + sb] = g1s[tid]; lrs[(size_t)gb * LCAP + sb] = rss[tid]; }
        __syncthreads();
    }
}

constexpr int MOE_TMAX = 144;
__device__ __forceinline__ void moe_tables_fill(const unsigned* cnt, volatile LAS unsigned* tab, volatile LAS unsigned* tmap) {
    const int lane = threadIdx.x & 63; int cl = 0;
    if (lane < 16) cl = (int)__hip_atomic_load(cnt + 64 * lane, __ATOMIC_RELAXED, __HIP_MEMORY_SCOPE_AGENT);
#pragma unroll
    for (int k = 0; k < 2; ++k) { int s = 0; int me = 0, mlt = 0; const int j = threadIdx.x;
#pragma unroll
        for (int e = 0; e < 8; ++e) { const int c = __builtin_amdgcn_readlane(cl, k * 8 + e);
            if (threadIdx.x == 0) { tab[32 * k + e] = (unsigned)s; tab[32 * k + 16 + e] = (unsigned)c; }
            const int nt = (c + 255) >> 8; if (j >= s && j < s + nt) { me = e; mlt = j - s; } s += nt; }
        if (threadIdx.x == 0) tab[32 * k + 8] = (unsigned)s;
        if (j < MOE_TMAX) tmap[MOE_TMAX * k + j] = (unsigned)((me << 16) | mlt); }
    __syncthreads();
}
__device__ __forceinline__ MoeTab moe_tab(volatile LAS unsigned* tab, volatile LAS unsigned* tmap, int k) { MoeTab T; T.ts = (const LAS int*)tab + 32 * k; T.cnt = (const LAS int*)tab + 32 * k + 16; T.tile = (const LAS int*)tmap + MOE_TMAX * k;
    T.nM = __builtin_amdgcn_readfirstlane(T.ts[8]); return T; }
#define XB_TMO      128
#define XB_XCNT(j)  (256  + 64 * (j))
#define XB_XSUB(j)  (1280 + 64 * (j))
#define XB_XGEN(j)  (2304 + 64 * (j))
#define XB_TOP      3328
#define XB_TOPGEN   3392
#define XCD_BAR_WORDS 3456
#define XB_SPIN_CAP (1u << 18)
__device__ __forceinline__ unsigned xb_ld(unsigned* p)              { return __hip_atomic_load(p, __ATOMIC_RELAXED, __HIP_MEMORY_SCOPE_AGENT); }
__device__ __forceinline__ unsigned xb_add(unsigned* p, unsigned v) { return __hip_atomic_fetch_add(p, v, __ATOMIC_RELAXED, __HIP_MEMORY_SCOPE_AGENT); }
__device__ __forceinline__ unsigned xb_xcc_id() { return (unsigned)__builtin_amdgcn_s_getreg((3 << 11) | 20) & 0xFu; }
#define XB_SPIN(cond, bar) do { unsigned _sp = 0; while (cond) { __builtin_amdgcn_s_sleep(1); \
    if ((++_sp & 255u) == 0u) { if (xb_ld(&(bar)[XB_TMO])) break; if (_sp > XB_SPIN_CAP) { atomicAdd(&(bar)[XB_TMO], 1u); break; } } } } while (0)
struct XcdBarrier { unsigned* bar; unsigned x; volatile LAS unsigned* st; };
__device__ __forceinline__ XcdBarrier xcd_barrier_post(unsigned* bar, volatile LAS unsigned* st) {
    XcdBarrier b; b.bar = bar; b.x = xb_xcc_id(); b.st = st;
    if (threadIdx.x == 0) (void)xb_add(&bar[XB_XCNT(b.x)], 1u);
    return b;
}
__device__ __forceinline__ void xcd_barrier_complete(unsigned* bar, unsigned x, unsigned& nloc, unsigned& nx) {
    const unsigned G = gridDim.x * gridDim.y * gridDim.z;
    unsigned sum, cnt, mine, sp = 0u;
    for (;;) {
        sum = 0u; cnt = 0u; mine = 0u;
#pragma unroll
        for (unsigned j = 0; j < 16; ++j) { const unsigned c = xb_ld(&bar[XB_XCNT(j)]); sum += c; cnt += (c > 0u) ? 1u : 0u; mine = (j == x) ? c : mine; }
        if (sum == G) break;
        __builtin_amdgcn_s_sleep(1);
        if ((++sp & 255u) == 0u) { if (xb_ld(&bar[XB_TMO])) break; if (sp > XB_SPIN_CAP) { atomicAdd(&bar[XB_TMO], 1u); break; } }
    }
    nloc = mine > 0u ? mine : 1u; nx = cnt > 0u ? cnt : 1u;
}
__device__ __forceinline__ void xcd_barrier(const XcdBarrier& b) {
    asm volatile("s_waitcnt vmcnt(0)" ::: "memory");
    __syncthreads();
    if (threadIdx.x == 0) {
        unsigned* bar = b.bar;
        __builtin_amdgcn_s_waitcnt(0);
        unsigned nloc = b.st[0], nx = b.st[1];
        if (nloc == 0u) { xcd_barrier_complete(bar, b.x, nloc, nx); b.st[0] = nloc; b.st[1] = nx; }
        const unsigned old = xb_add(&bar[XB_XSUB(b.x)], 1u);
        const unsigned gen = old / nloc;
        if (old + 1u == (gen + 1u) * nloc) {
            __builtin_amdgcn_fence(__ATOMIC_RELEASE, "agent");
            asm volatile("s_waitcnt vmcnt(0)" ::: "memory");
            const unsigned og = xb_add(&bar[XB_TOP], 1u);
            const unsigned tg = og / nx;
            if (og + 1u == (tg + 1u) * nx) xb_add(&bar[XB_TOPGEN], 1u);
            else XB_SPIN(xb_ld(&bar[XB_TOPGEN]) == tg, bar);
            __builtin_amdgcn_fence(__ATOMIC_ACQUIRE, "agent");
            xb_add(&bar[XB_XGEN(b.x)], 1u);
            asm volatile("s_waitcnt vmcnt(0)" ::: "memory");
        } else {
            XB_SPIN(xb_ld(&bar[XB_XGEN(b.x)]) == gen, bar);
            __builtin_amdgcn_fence(__ATOMIC_ACQUIRE, "agent");
            asm volatile("s_waitcnt vmcnt(0)" ::: "memory");
        }
    }
    __syncthreads();
}

constexpr int RING_BYTES = 131072, LDS_TOK = RING_BYTES, LDSCTL_OFF = RING_BYTES + 1024 + 3 * pg8::AUX_BUF, LDS_BYTES = 147456;
static_assert(LDSCTL_OFF + 1024 + 2 * MOE_TMAX * 4 <= LDS_BYTES, "LDS map");
static_assert(AL_END <= RING_BYTES && BL_END <= RING_BYTES && CL_END <= RING_BYTES && pg8::TOK_LDS_OFF == LDS_TOK, "LDS map");

#ifndef MK_PER_PHASE
#define MK_PER_PHASE 0
#endif
#ifndef PH_LIMIT
#define PH_LIMIT 15
#endif
constexpr int N_PHASES = PH_LIMIT;

struct Args { const float* in[21]; float* out; unsigned char* ws; int ph_lo, ph_hi; };

template <int L> __device__ __forceinline__ void mixer_phase(const Args& a, LAS unsigned char* lds, volatile LAS unsigned* MISC, gu32* ctl, int qrep) {
    unsigned char* ws = a.ws; unsigned char* ms = ws + WS_MISC;
    const bf16_t* Z = (const bf16_t*)(ws + WS_Z); bf16_t* mix = (bf16_t*)(ws + WS_MIX); bf16_t* mixm = (bf16_t*)(ms + MS_MIXM);
    const float* lutA = (const float*)(ms + MS_LUTA); const float* lutB = (const float*)(ms + MS_LUTB); const float* btiles = (const float*)(ms + MS_BT); const int* bchkp = (const int*)(ms + MS_BCHK) + L * 4; const int bchk4 = __builtin_amdgcn_readfirstlane((bchkp[0] != 0 ? 1 : 0) | (bchkp[1] != 0 ? 2 : 0) | (bchkp[2] != 0 ? 4 : 0) | (bchkp[3] != 0 ? 8 : 0));
    const float lam = ((const float*)(ms + MS_LAM))[L]; const float omli = 1.0f - (0.8f - 0.6f * __expf(-0.3f * (float)L));
    const float* sinks = a.in[6] + L * 8; const float* gout = a.in[9] + L * 64; const float* pscale = a.in[11] + L * 256;
    const bf16_t* wpt = (const bf16_t*)(ms + MS_WPT) + (size_t)L * 4 * 64 * 64;
    constexpr int NBU = 1024, NBM = (L == 0) ? 4 : 0, NAU = 512, NAM = (L == 0) ? 2 : 0, NCU = 512, NCM = (L == 0) ? 1 : 0;
#define QPOP(q) __hip_atomic_fetch_add(ctl + CW_QUEUE + 64 * (6 * L + (q) + 12 * qrep), 1u, __ATOMIC_RELAXED, __HIP_MEMORY_SCOPE_AGENT)
#define QPOP_ASYNC(q) __hip_atomic_fetch_add(ctl + CW_QUEUE + 64 * (6 * L + (q) + 12 * qrep) + qzero, 1u, __ATOMIC_RELAXED, __HIP_MEMORY_SCOPE_AGENT)
#define QUEUE_LOOP(q, END, BODY) { unsigned pf = 0u; unsigned qzero = 0u; asm volatile("" : "+v"(qzero)); if (threadIdx.x == 0) MISC[4] = QPOP(q); __syncthreads(); int u = (int)MISC[4]; __syncthreads(); \
        while (u < (END)) { if (threadIdx.x == 0) pf = QPOP_ASYNC(q); BODY \
            if (threadIdx.x == 0) MISC[4] = pf; __syncthreads(); u = (int)MISC[4]; __syncthreads(); } }
#ifndef MIXREP
#define MIXREP 0
#endif
#define LOOP_B(qq) QUEUE_LOOP(qq, NBU + NBM, \
        if (u < NBU) { const int ib = 16 - (u >> 6); const int r = u & 63; attnB_unit(lds, r >> 2, r & 3, ib, Z, mix, mixm, lutB, btiles, ((bchk4 >> (r & 3)) & 1) != 0, lam, omli, gout); } \
        else attnB_unit(lds, 0, u - NBU, 0, Z, mix, mixm, lutB, btiles, ((bchk4 >> (u - NBU)) & 1) != 0, lam, omli, gout); )
#define LOOP_A(qq) QUEUE_LOOP(qq, NAU + NAM, \
        if (u < NAU) { const int ib = 1 + (u & 15); const int r = u >> 4; attnA_unit(lds, r >> 1, r & 1, ib, Z, mix, mixm, lutA, sinks); } \
        else attnA_unit(lds, 0, u - NAU, 0, Z, mix, mixm, lutA, sinks); )
#define LOOP_C(qq) QUEUE_LOOP(qq, NCU + NCM, \
        if (u < NCU) pool_unit(lds, u >> 5, 2 + (u & 31), Z, mix, mixm, wpt, pscale); \
        else pool_unit(lds, 0, 1, Z, mix, mixm, wpt, pscale); )
    LOOP_B(0)
    if (MIXREP & 1) { LOOP_B(3) }
    LOOP_A(1)
    if (MIXREP & 2) { LOOP_A(4) }
    LOOP_C(2)
    if (MIXREP & 4) { LOOP_C(5) }
#undef LOOP_A
#undef LOOP_B
#undef LOOP_C
#undef QUEUE_LOOP
#undef QPOP
#undef QPOP_ASYNC
}

__global__ void __launch_bounds__(NTHREADS, 2) fwd_kernel(Args a) {
    extern __shared__ __attribute__((aligned(16))) unsigned char lds_raw[];
    LAS unsigned char* lds = (LAS unsigned char*)lds_raw;
    volatile LAS unsigned* MISC = (volatile LAS unsigned*)(lds + LDSCTL_OFF);
    const int tid = threadIdx.x;
    const int G = gridDim.x, bx = blockIdx.x, vcu = (G % 8 == 0) ? (bx % 8) * (G / 8) + bx / 8 : bx;
    unsigned char* ws = a.ws; unsigned char* ms = ws + WS_MISC;
    gu32* ctl = (gu32*)(ws + WS_CTL);
    for (int u = tid; u < 64; u += NTHREADS) MISC[u] = 0u;
    __syncthreads();
    XcdBarrier bar; bar.bar = (unsigned*)(ctl + CW_BAR); bar.x = 0; bar.st = nullptr;
    if (!MK_PER_PHASE) bar = xcd_barrier_post((unsigned*)(ctl + CW_BAR), MISC + 8);
    const int lo = a.ph_lo, hi = a.ph_hi;
#ifndef PH_MASK
#define PH_MASK 0xffffffffu
#endif
#define IN(k) (((PH_MASK >> (k)) & 1u) && lo <= (k) && (k) < hi)
#define SEAM(k) do { if (IN(k) && IN((k) + 1)) xcd_barrier(bar); } while (0)
#ifndef REP_MASK
#define REP_MASK 0u
#endif
#define REPS(k) (((REP_MASK >> (k)) & 1u) ? 2 : 1)
    bf16_t* HB = (bf16_t*)(ws + WS_HB); float* SSP = (float*)(ms + MS_SSP);
    bf16_t* Zb = (bf16_t*)(ws + WS_Z); bf16_t* MIX = (bf16_t*)(ws + WS_MIX);
    float* HM = (float*)(ms + MS_HM); bf16_t* HMB = (bf16_t*)(ms + MS_HMB); float* SSPM = (float*)(ms + MS_SSPM); bf16_t* MIXM = (bf16_t*)(ms + MS_MIXM); bf16_t* ACTM = (bf16_t*)(ms + MS_ACTM);
    const float* GT = (const float*)(ms + MS_GT);
    LAS float* ROWSUM = (LAS float*)(lds + pg8::AUX_LDS_OFF);
    const int mj0 = G - 1 - bx;

    if (IN(0)) _Pragma("unroll") for (int rep = 0; rep < REPS(0); ++rep) { if (rep) xcd_barrier(bar);
        ProArgs P; P.x = a.in[0]; P.meta = a.in[1]; P.relb = a.in[2]; P.g_mix = a.in[3]; P.w_in = a.in[4]; P.gain_a = a.in[5]; P.gain_b = a.in[7]; P.dlam = a.in[8]; P.w_pool = a.in[10];
        P.w_out = a.in[12]; P.g_ffn = a.in[13]; P.wg = a.in[14]; P.wu = a.in[15]; P.wd = a.in[16]; P.w_router = a.in[17]; P.weg = a.in[18]; P.weu = a.in[19]; P.wed = a.in[20]; P.ws = ws;
        prologue(P, lds, vcu, G);
    }
    SEAM(0);
    if (IN(1)) _Pragma("unroll") for (int rep = 0; rep < REPS(1); ++rep) { if (rep) xcd_barrier(bar);
        for (int j = mj0; j < 28; j += G) meta_inproj_unit(lds, j, HMB, (const bf16_t*)(ws + WS_WIN), SSPM, GT, Zb);
        SchedDenseT<4, DIN / 256> S{M / 256, G, bx, (const char*)HB, (const char*)(ws + WS_WIN), (size_t)256 * D * 2, SSP};
        LAS float* GL = (LAS float*)(lds + LDSCTL_OFF + 1024); if (tid < 256) GL[tid] = GT[tid]; __syncthreads();
        EpiInProj E{Zb, SSP, GL};
        pg8::gemm_phase(lds, 2 * D, S, E);
    }
    SEAM(1);
    if (IN(2)) { mixer_phase<0>(a, lds, MISC, ctl, 0); if (REPS(2) > 1) { xcd_barrier(bar); mixer_phase<0>(a, lds, MISC, ctl, 1); } }
    SEAM(2);
    if (IN(3)) _Pragma("unroll") for (int rep = 0; rep < REPS(3); ++rep) { if (rep) xcd_barrier(bar);
        for (int j = mj0; j < 16; j += G) meta_res_unit(lds, j, MIXM, (const bf16_t*)(ws + WS_WOUT), D, HM, HMB, SSPM);
        SchedDenseT<0, D / 256> S{M / 256, G, bx, (const char*)MIX, (const char*)(ws + WS_WOUT), (size_t)256 * D * 2, SSP};
        EpiRes<1> E{nullptr, HB, SSP, nullptr, ROWSUM};
        pg8::gemm_phase(lds, 2 * D, S, E);
    }
    SEAM(3);
    if (IN(4)) _Pragma("unroll") for (int rep = 0; rep < REPS(4); ++rep) { if (rep) xcd_barrier(bar);
        for (int j = mj0; j < 88; j += G) meta_ffnup_unit(lds, j, HMB, (const bf16_t*)(ws + WS_WGU), SSPM, ACTM);
        SchedDenseT<4, 2 * DFF / 256> S{M / 256, G, bx, (const char*)HB, (const char*)(ws + WS_WGU), (size_t)256 * D * 2, SSP};
        EpiSwiglu E{(bf16_t*)(ws + WS_ACT), SSP};
        pg8::gemm_phase(lds, 2 * D, S, E);
    }
    SEAM(4);
    if (IN(5)) {
        for (int j = mj0; j < 16; j += G) meta_res_unit(lds, j, ACTM, (const bf16_t*)(ws + WS_WD), DFF, HM, HMB, SSPM);
        SchedDenseT<0, D / 256> S{M / 256, G, bx, (const char*)(ws + WS_ACT), (const char*)(ws + WS_WD), (size_t)256 * DFF * 2, SSP};
        EpiRes<1> E{nullptr, HB, SSP, nullptr, ROWSUM};
        pg8::gemm_phase(lds, 2 * DFF, S, E);
    }
    SEAM(5);
    if (IN(6)) _Pragma("unroll") for (int rep = 0; rep < REPS(6); ++rep) { if (rep) xcd_barrier(bar);
        for (int j = mj0; j < 28; j += G) meta_inproj_unit(lds, j, HMB, (const bf16_t*)(ws + WS_WIN) + (size_t)DIN * D, SSPM, GT + 256, Zb);
        SchedDenseT<4, DIN / 256> S{M / 256, G, bx, (const char*)HB, (const char*)(ws + WS_WIN) + (size_t)DIN * D * 2, (size_t)256 * D * 2, SSP};
        LAS float* GL = (LAS float*)(lds + LDSCTL_OFF + 1024); if (tid < 256) GL[tid] = GT[256 + tid]; __syncthreads();
        EpiInProj E{Zb, SSP, GL};
        pg8::gemm_phase(lds, 2 * D, S, E);
    }
    SEAM(6);
    if (IN(7)) { mixer_phase<1>(a, lds, MISC, ctl, 0); if (REPS(7) > 1) { xcd_barrier(bar); mixer_phase<1>(a, lds, MISC, ctl, 1); } }
    SEAM(7);
    if (IN(8)) {
        SchedDenseT<0, D / 256> S{M / 256, G, bx, (const char*)MIX, (const char*)(ws + WS_WOUT) + (size_t)D * D * 2, (size_t)256 * D * 2, SSP};
        EpiRes<2> E{nullptr, HB, SSP, ws + WS_HB8, ROWSUM};
        pg8::gemm_phase(lds, 2 * D, S, E);
    }
    SEAM(8);
    float* LRS = (float*)(ms + MS_LRS); int* LTOK = (int*)(ms + MS_LTOK); float* LGATE = (float*)(ms + MS_LGATE);
    if (IN(9)) router_phase(lds, HB, (const bf16_t*)(ms + MS_WRB), SSP, LRS, LTOK, LGATE, (unsigned*)(ctl + CW_CNT), vcu, G);
    SEAM(9);
    volatile LAS unsigned* TMAP = (volatile LAS unsigned*)(lds + LDSCTL_OFF + 1024);
    if (hi > 10) moe_tables_fill((const unsigned*)(ctl + CW_CNT), MISC + 16, TMAP);
    const MoeTab MT0 = moe_tab(MISC + 16, TMAP, 0), MT1 = moe_tab(MISC + 16, TMAP, 1);
#define MT(k) ((k) ? MT1 : MT0)
    if (IN(10)) {
        SchedMoeUp S{MT(0), MT(1), G, bx, (const char*)(ws + WS_HB8), (const char*)(ws + WS_WEGU), LTOK, LRS};
        EpiSwigluMoe E{ws + WS_ACTE, LRS, MT(0), MT(1)};
        pg8::gemm_phase(lds, D, S, E);
    }
    SEAM(10);
    if (IN(11)) {
        SchedMoeDown S{MT(0), G, bx, 0, (const char*)(ws + WS_ACTE), (const char*)(ws + WS_WED), LTOK, LGATE, 0, 0}; S.init();
        EpiMoeDown<true> E{a.out, HB, LTOK, LGATE, MT(0), 0, (float*)(ws + WS_PART)};
        pg8::gemm_phase(lds, DFE, S, E);
    }
    SEAM(11);
    if (IN(12)) moe_reduce<true>(MT(0), 0, G, a.out, HB, LTOK, LGATE, (const float*)(ws + WS_PART), vcu * NWAVES + (tid >> 6), G * NWAVES, tid & 63);
    SEAM(12);
    if (IN(13)) {
        SchedMoeDown S{MT(1), G, bx, 1, (const char*)(ws + WS_ACTE + ACTE_BYTES), (const char*)(ws + WS_WED), LTOK, LGATE, 0, 0}; S.init();
        EpiMoeDown<false> E{a.out, HB, LTOK, LGATE, MT(1), 1, (float*)(ws + WS_PART)};
        pg8::gemm_phase(lds, DFE, S, E);
    }
    SEAM(13);
    if (IN(14)) moe_reduce<false>(MT(1), 1, G, a.out, HB, LTOK, LGATE, (const float*)(ws + WS_PART), vcu * NWAVES + (tid >> 6), G * NWAVES, tid & 63);
#undef MT
#undef IN
#undef SEAM
}

#ifdef DUMP_OFF
__global__ void dump_bf16(const bf16_t* src, float* out, size_t n) { for (size_t i = (size_t)blockIdx.x * blockDim.x + threadIdx.x; i < n; i += (size_t)gridDim.x * blockDim.x) out[i] = __uint_as_float((unsigned)src[i] << 16); }
#endif
extern "C" void kernel_launch(void* const* d_in, const int* in_sizes, int n_in, void* d_out, int out_size, void* d_ws, size_t ws_size, hipStream_t stream) {
    static int grid = 0;
    if (grid == 0) {
        if (n_in != 21 || in_sizes[0] != M * D || out_size != M * D || ws_size < WS_END) { fprintf(stderr, "kernel_launch: unexpected shapes (n_in %d, in0 %d, out %d, ws %zu < %zu); nothing launched\n", n_in, n_in > 0 ? in_sizes[0] : -1, out_size, ws_size, (size_t)WS_END); grid = -1; return; }
        int dev = 0, cus = 0, per_cu = 0;
        if (hipGetDevice(&dev) != hipSuccess || hipDeviceGetAttribute(&cus, hipDeviceAttributeMultiprocessorCount, dev) != hipSuccess) { grid = -1; return; }
        if (hipFuncSetAttribute((const void*)fwd_kernel, hipFuncAttributeMaxDynamicSharedMemorySize, LDS_BYTES) != hipSuccess) { fprintf(stderr, "kernel_launch: hipFuncSetAttribute failed\n"); grid = -1; return; }
        if (hipOccupancyMaxActiveBlocksPerMultiprocessor(&per_cu, (const void*)fwd_kernel, NTHREADS, LDS_BYTES) != hipSuccess || per_cu < 1) { fprintf(stderr, "kernel_launch: occupancy query reports %d workgroups per CU\n", per_cu); }
        (void)hipGetLastError();
        grid = cus;
    }
    if (grid < 0) return;
    if (hipMemsetAsync((char*)d_ws + WS_CTL, 0, CTL_ZERO_BYTES, stream) != hipSuccess) return;
    Args a{};
    for (int i = 0; i < 21; ++i) a.in[i] = (const float*)d_in[i];
    a.out = (float*)d_out; a.ws = (unsigned char*)d_ws;
#if MK_PER_PHASE
    for (int p = 0; p < N_PHASES; ++p) { a.ph_lo = p; a.ph_hi = p + 1; hipLaunchKernelGGL(fwd_kernel, dim3(grid), dim3(NTHREADS), LDS_BYTES, stream, a); }
#ifdef DUMP_OFF
    hipLaunchKernelGGL(dump_bf16, dim3(2048), dim3(256), 0, stream, (const bf16_t*)((const char*)d_ws + (DUMP_OFF)), (float*)d_out, (size_t)(DUMP_N));
#endif
#else
    a.ph_lo = 0; a.ph_hi = N_PHASES; hipLaunchKernelGGL(fwd_kernel, dim3(grid), dim3(NTHREADS), LDS_BYTES, stream, a);
#endif
}
```

```cpp
#include <hip/hip_runtime.h>
#include <cstdio>
#include <cstdint>

#define LAS __attribute__((address_space(3)))
#define GAS __attribute__((address_space(1)))
typedef unsigned short bf16_t;
typedef short bf16x8 __attribute__((ext_vector_type(8)));
typedef short s16x4 __attribute__((ext_vector_type(4)));
typedef float f32x2 __attribute__((ext_vector_type(2)));
typedef float f32x4 __attribute__((ext_vector_type(4)));
typedef float f32x16 __attribute__((ext_vector_type(16)));
typedef unsigned u32x2 __attribute__((ext_vector_type(2)));
typedef unsigned u32x4 __attribute__((ext_vector_type(4)));
typedef GAS unsigned gu32;

constexpr int D = 1024, NBATCH = 16, SEQ = 2048, M = NBATCH * SEQ, NMETA = 16;
constexpr int LP = 2176;
constexpr int PADP = 112;
constexpr int DIN = 1792, DFF = 2816, NE = 8, DFE = 3584;
constexpr int ZQA = 0, ZKA = 512, ZVA = 640, ZQB = 768, ZKB = 1024, ZVB = 1280, ZUC = 1536;
constexpr float EPS = 1e-6f, NEGF = -1e30f, LOG2E = 1.4426950408889634f;
constexpr int NWAVES = 8, NTHREADS = 512;

constexpr size_t MiB = 1u << 20;
constexpr size_t WS_CTL = 0, CTL_ZERO_BYTES = 96 * 1024;
constexpr size_t WS_WEGU = 1 * MiB;
constexpr size_t WS_WED = WS_WEGU + (size_t)NE * 2 * DFE * D;
constexpr size_t WS_HB8 = WS_WED + (size_t)NE * D * DFE;
constexpr size_t WS_MISC = WS_HB8 + (size_t)M * D;
constexpr size_t WS_R = WS_MISC + 10 * MiB;
constexpr size_t WS_HB = WS_R;
constexpr size_t WS_Z = WS_HB + (size_t)M * D * 2;
constexpr size_t Z_BYTES = (size_t)NBATCH * LP * DIN * 2;
constexpr size_t WS_MIX = WS_Z + ((Z_BYTES + MiB - 1) / MiB) * MiB;
constexpr size_t WS_WIN = WS_MIX + (size_t)M * D * 2;
constexpr size_t WS_WOUT = WS_WIN + (size_t)2 * DIN * D * 2;
constexpr size_t WS_WGU = WS_WOUT + (size_t)2 * D * D * 2;
constexpr size_t WS_WD = WS_WGU + (size_t)2 * DFF * D * 2;
constexpr size_t WS_ACT = WS_Z;
constexpr int ACTE_ROWS = M + NE * 256;
constexpr size_t ACTE_BYTES = (size_t)ACTE_ROWS * DFE;
constexpr size_t WS_ACTE = WS_Z;
constexpr size_t WS_PART = WS_ACTE + 2 * ACTE_BYTES;
constexpr size_t WS_END_A = WS_WD + (size_t)D * DFF * 2, WS_END_B = WS_PART + (size_t)224 * 65536 * 4;
constexpr size_t WS_END = WS_END_A > WS_END_B ? WS_END_A : WS_END_B;
static_assert(WS_ACT + (size_t)M * DFF * 2 <= WS_WIN, "dense hidden must not touch the converted weights");
constexpr int WEGU_SH = 5, WED_SH = 6, ACT_SH = 2;
constexpr size_t MS_SSP = 0;
constexpr size_t MS_LTOK = MS_SSP + (size_t)M * 16 * 4;
constexpr int LCAP = M + 256;
constexpr size_t MS_LGATE = MS_LTOK + (size_t)16 * LCAP * 4;
constexpr size_t MS_LRS = MS_LGATE + (size_t)16 * LCAP * 4;
constexpr size_t MS_HM = MS_LRS + (size_t)16 * LCAP * 4;
constexpr size_t MS_HMB = MS_HM + 16 * 1024 * 4;
constexpr size_t MS_SSPM = MS_HMB + 16 * 1024 * 2;
constexpr size_t MS_MIXM = MS_SSPM + 1024;
constexpr size_t MS_ACTM = MS_MIXM + 16 * 1024 * 2;
constexpr size_t MS_LUTA = MS_ACTM + 16 * 2816 * 2;
constexpr size_t MS_LUTB = MS_LUTA + 8 * 128 * 4;
constexpr size_t MS_WPT = MS_LUTB + 4 * 128 * 4;
constexpr size_t MS_WR = MS_WPT + 2 * 4 * 64 * 64 * 2;
constexpr size_t MS_END = MS_WR + 1024 * 8 * 4;
static_assert(MS_END <= 9 * MiB, "misc map");
constexpr int CW_BAR = 4096;
constexpr int CW_QUEUE = 16384;
constexpr int CW_CNT = 20480;
static_assert((CW_CNT + 64 * 32) * 4 <= (int)CTL_ZERO_BYTES && (CW_QUEUE + 64 * 64) <= CW_CNT, "control words inside the zeroed range");

typedef __bf16 bf16x2_t __attribute__((ext_vector_type(2)));
__device__ __forceinline__ unsigned cvt_pk_bf16(float lo, float hi) { const bf16x2_t r = __builtin_convertvector((f32x2){lo, hi}, bf16x2_t); return __builtin_bit_cast(unsigned, r); }
__device__ __forceinline__ unsigned pack4_fp8(float a, float b, float c, float d) { int w = 0; w = __builtin_amdgcn_cvt_pk_fp8_f32(a, b, w, false); w = __builtin_amdgcn_cvt_pk_fp8_f32(c, d, w, true); return (unsigned)w; }
__device__ __forceinline__ float bf16_lo(unsigned w) { return __uint_as_float(w << 16); }
__device__ __forceinline__ float bf16_hi(unsigned w) { return __uint_as_float(w & 0xffff0000u); }
template <int CTRL> __device__ __forceinline__ float dpp_mov(float v) { return __int_as_float(__builtin_amdgcn_update_dpp(0, __float_as_int(v), CTRL, 0xf, 0xf, true)); }
__device__ __forceinline__ float xor16_add(float v) { const auto r = __builtin_amdgcn_permlane16_swap(__float_as_uint(v), __float_as_uint(v), false, false); return __uint_as_float(r[0]) + __uint_as_float(r[1]); }
__device__ __forceinline__ float xor32_add(float v) { const auto r = __builtin_amdgcn_permlane32_swap(__float_as_uint(v), __float_as_uint(v), false, false); return __uint_as_float(r[0]) + __uint_as_float(r[1]); }
__device__ __forceinline__ float xor32_max(float v) { const auto r = __builtin_amdgcn_permlane32_swap(__float_as_uint(v), __float_as_uint(v), false, false); return fmaxf(__uint_as_float(r[0]), __uint_as_float(r[1])); }
__device__ __forceinline__ float wave_sum(float v) {
    v += dpp_mov<0xB1>(v);
    v += dpp_mov<0x4E>(v);
    v += dpp_mov<0x141>(v);
    v += dpp_mov<0x140>(v);
    return xor32_add(xor16_add(v));
}
#define LDS_WAIT() asm volatile("s_waitcnt lgkmcnt(0)" ::: "memory")
#define VM_WAIT() asm volatile("s_waitcnt vmcnt(0)" ::: "memory")
namespace pg8 {
constexpr int BM = 256, BK = 64, HALF = 128, HTB = HALF * BK * 2, STAGE_BYTES = 8 * HTB, NXCD = 8, WGM = 8;
constexpr int TOK_LDS_OFF = STAGE_BYTES;
constexpr int AUX_BUF = 4096;
constexpr int AUX_LDS_OFF = STAGE_BYTES + 1024;

__host__ __device__ __forceinline__ int lds_byte(int r, int c) { const int st = (r >> 4) * 2 + (c >> 5), rr = r & 15, cc = c & 31, ob = rr * 64 + cc * 2; return st * 1024 + (ob ^ (((ob >> 9) & 1) << 5)); }
__host__ __device__ __forceinline__ void stage_rc(int b, int& R, int& C) { const int st = b / 1024, sb = b % 1024, swz = sb ^ (((sb >> 9) & 1) << 5); R = (st >> 1) * 16 + swz / 64; C = (st & 1) * 32 + (swz % 64) / 2; }
__host__ __device__ __forceinline__ int perm32(int rho) { const int n = rho >> 4, i = rho & 15; return 8 * (i >> 2) + 4 * n + (i & 3); }

typedef int v8i32 __attribute__((ext_vector_type(8))); typedef int v4i32 __attribute__((ext_vector_type(4)));
__device__ __forceinline__ v8i32 cat8(bf16x8 a, bf16x8 b) { const v4i32 x = __builtin_bit_cast(v4i32, a), y = __builtin_bit_cast(v4i32, b); return __builtin_shufflevector(x, y, 0, 1, 2, 3, 4, 5, 6, 7); }
__device__ __forceinline__ void mfma_fp8(f32x4& acc, const v8i32& w, const v8i32& x, int sw, int sx) {
    asm volatile("s_nop 1\n\tv_mfma_scale_f32_16x16x128_f8f6f4 %0, %1, %2, %0, %3, %4 op_sel_hi:[0,0,0]" : "+v"(acc) : "v"(w), "v"(x), "v"(sw), "v"(sx));
}
__device__ __forceinline__ void mfma_fp8_z(f32x4& acc, const v8i32& w, const v8i32& x, int sw, int sx) {
    asm volatile("s_nop 1\n\tv_mfma_scale_f32_16x16x128_f8f6f4 %0, %1, %2, 0, %3, %4 op_sel_hi:[0,0,0]" : "=&v"(acc) : "v"(w), "v"(x), "v"(sw), "v"(sx));
}
struct Unit { int pm, pn, aux, kc, slab; };

template <int NN> __device__ __forceinline__ void order_map(int nM, int L, int& pm, int& pn) {
    const int nwg = nM * NN;
    int wgid = L; { const int q = nwg >> 3, r = nwg & 7, xcd = wgid & 7, off = wgid >> 3; wgid = (xcd < r ? xcd * (q + 1) : r * (q + 1) + (xcd - r) * q) + off; }
    constexpr int nig = WGM * NN; const int gid = wgid / nig, fm = gid * WGM, rem = wgid - gid * nig;
    if (fm + WGM <= nM) { pm = fm + (rem & (WGM - 1)); pn = rem / WGM; }
    else { pm = fm + rem / NN; pn = rem % NN; }
}
template <int NN> __device__ __forceinline__ bool static_order(int nM, int G, int c, int i, int& pm, int& pn) {
    const int L = i * G + c; if (L >= nM * NN) return false;
    order_map<NN>(nM, L, pm, pn); return true;
}

template <class Epi, class Sched>
__device__ __forceinline__ void gemm_phase(LAS unsigned char* lds, const int KB  , const Sched& S, const Epi& E) {
    const int tid = threadIdx.x, wid = __builtin_amdgcn_readfirstlane(tid >> 6), lane = tid & 63, wr = wid >> 2, wc = wid & 3, fr = lane & 15, fq = lane >> 4;
    const int nt = KB / 128;
    constexpr bool G = Sched::GATHER;
    unsigned voffB[2], aoC[2][2], aoN[2][2]; int rowA[2]; unsigned colA[2];
    const unsigned hstep = (unsigned)HALF * KB;
#pragma unroll
    for (int i = 0; i < 2; ++i) { int R, C; stage_rc(tid * 16 + i * 8192, R, C); const int Rb = (R & ~31) + perm32(R & 31);
        voffB[i] = (unsigned)(Rb * KB + C * 2); rowA[i] = R; colA[i] = (unsigned)C * 2u;
        aoC[0][i] = (unsigned)(R * KB + C * 2); aoC[1][i] = aoC[0][i] + hstep; aoN[0][i] = aoC[0][i]; aoN[1][i] = aoC[1][i]; }
    const size_t kstep = (size_t)(BK * 2);
    const unsigned ldsw = (unsigned)wid * 1024u;
    const int aoff = lds_byte(wr * 64 + fr, fq * 8), boff = lds_byte(wc * 32 + fr, fq * 8);
#define PG8_SA(b, h) (((b) * 2 + (h)) * HTB)
#define PG8_SB(b, h) ((4 + (b) * 2 + (h)) * HTB)
#define PG8_STAGE2(bufoff, gbase, o0, o1) do { \
        __builtin_amdgcn_global_load_lds((const unsigned*)((const char*)(gbase) + (o0)), (LAS unsigned*)(lds + (bufoff) + ldsw), 16, 0, 0); \
        __builtin_amdgcn_global_load_lds((const unsigned*)((const char*)(gbase) + (o1)), (LAS unsigned*)(lds + (bufoff) + ldsw + 8192), 16, 0, 0); } while (0)
#define PG8_STB(bufoff, gbase) PG8_STAGE2(bufoff, gbase, voffB[0], voffB[1])
#define PG8_LDA(dst, b, h) do { _Pragma("unroll") for (int m = 0; m < 4; ++m) { if constexpr (Sched::FP8) dst##8[m] = cat8(*(const LAS bf16x8*)(lds + PG8_SA(b, h) + aoff + m * 2048), *(const LAS bf16x8*)(lds + PG8_SA(b, h) + aoff + m * 2048 + 1024)); \
        else { _Pragma("unroll") for (int k = 0; k < 2; ++k) dst[m][k] = *(const LAS bf16x8*)(lds + PG8_SA(b, h) + aoff + m * 2048 + k * 1024); } } } while (0)
#define PG8_LDB(dst, b, h) do { _Pragma("unroll") for (int n = 0; n < 2; ++n) { if constexpr (Sched::FP8) dst##8[n] = cat8(*(const LAS bf16x8*)(lds + PG8_SB(b, h) + boff + n * 2048), *(const LAS bf16x8*)(lds + PG8_SB(b, h) + boff + n * 2048 + 1024)); \
        else { _Pragma("unroll") for (int k = 0; k < 2; ++k) dst[n][k] = *(const LAS bf16x8*)(lds + PG8_SB(b, h) + boff + n * 2048 + k * 1024); } } } while (0)
#define PG8_MMA(ai, bj, At, Bt, Z) do { __builtin_amdgcn_s_setprio(1); _Pragma("unroll") for (int m = 0; m < 4; ++m) _Pragma("unroll") for (int n = 0; n < 2; ++n) { \
        if constexpr (Sched::FP8) { if constexpr (Z) mfma_fp8_z(acc[ai][bj][m][n], Bt##8[n], At##8[m], scale_w, scale_x); else mfma_fp8(acc[ai][bj][m][n], Bt##8[n], At##8[m], scale_w, scale_x); } \
        else { _Pragma("unroll") for (int k = 0; k < 2; ++k) acc[ai][bj][m][n] = __builtin_amdgcn_mfma_f32_16x16x32_bf16(Bt[n][k], At[m][k], (Z && k == 0) ? (f32x4){0.f, 0.f, 0.f, 0.f} : acc[ai][bj][m][n], 0, 0, 0); } } __builtin_amdgcn_s_setprio(0); } while (0)
#define PG8_WAIT_V(n) asm volatile("s_waitcnt vmcnt(" #n ")" ::: "memory")
#define PG8_WAIT_L(n) asm volatile("s_waitcnt lgkmcnt(" #n ")" ::: "memory")
#define PG8_BAR __builtin_amdgcn_s_barrier()
#define PG8_SCHED __builtin_amdgcn_sched_barrier(0)
    Unit cur, nxt; int ui = 0;
    if (!S.next(0, cur)) return;
    int scale_w = Sched::SCALE_W, scale_x = Sched::SCALE_X; asm volatile("" : "+v"(scale_w), "+v"(scale_x));
    f32x4 acc[2][2][4][2];
#define PG8_ZERO_ACC do { if constexpr (!Sched::FP8) { _Pragma("unroll") for (int a = 0; a < 2; ++a) _Pragma("unroll") for (int b = 0; b < 2; ++b) _Pragma("unroll") for (int m = 0; m < 4; ++m) _Pragma("unroll") for (int n = 0; n < 2; ++n) { double z0, z1; asm volatile("v_mov_b64 %0, 0" : "=v"(z0)); asm volatile("v_mov_b64 %0, 0" : "=v"(z1)); const f32x2 p0 = __builtin_bit_cast(f32x2, z0), p1 = __builtin_bit_cast(f32x2, z1); acc[a][b][m][n] = (f32x4){p0[0], p0[1], p1[0], p1[1]}; } } } while (0)
    PG8_ZERO_ACC;
    bf16x8 At[4][2], B0[2][2], B1[2][2]; v8i32 At8[4], B08[2], B18[2];
    const char* cA = S.a_ptr(cur); const char* cB = S.b_ptr(cur);
    if constexpr (G) {
        const int* lp = S.list_ptr(cur); const int cnt = S.list_cnt(cur);
#pragma unroll
        for (int h = 0; h < 2; ++h)
#pragma unroll
            for (int i = 0; i < 2; ++i) { const int r = rowA[i] + HALF * h; const int id = r < cnt ? lp[r] : 0; aoC[h][i] = (unsigned)id * (unsigned)KB + colA[i]; }
    }
    if constexpr (Sched::AUX_OPS > 0) { if (wid >= 1 && wid <= Sched::AUX_OPS) __builtin_amdgcn_global_load_lds((const unsigned*)(S.aux_ptr(cur, wid - 1) + lane * 4), (LAS unsigned*)(lds + AUX_LDS_OFF + (wid - 1) * 1024), 16, 0, 0); }
    PG8_STB(PG8_SB(0, 0), cB); PG8_STB(PG8_SB(0, 1), cB + hstep); PG8_STAGE2(PG8_SA(0, 0), cA, aoC[0][0], aoC[0][1]); PG8_STAGE2(PG8_SA(0, 1), cA, aoC[1][0], aoC[1][1]);
    if (wr == 1) PG8_BAR;
    PG8_WAIT_V(2); PG8_BAR;
    PG8_STB(PG8_SB(1, 0), cB + kstep); PG8_STAGE2(PG8_SA(1, 0), cA + kstep, aoC[0][0], aoC[0][1]); PG8_STB(PG8_SB(1, 1), cB + hstep + kstep);
    PG8_WAIT_V(6); PG8_BAR;
    for (;;) {
        const bool has_next = S.next(ui + 1, nxt);
        int ntc = nt; if constexpr (Sched::VARK) ntc = S.nt_of(cur);
        const char* nA = has_next ? S.a_ptr(nxt) : cA; const char* nB = has_next ? S.b_ptr(nxt) : cB;
        int ncnt = 0;
        if constexpr (G) {
            if (has_next) { ncnt = S.list_cnt(nxt); if (wid == 0) __builtin_amdgcn_global_load_lds((const unsigned*)(S.list_ptr(nxt) + lane * 4), (LAS unsigned*)(lds + TOK_LDS_OFF), 16, 0, 0); }
        }
        if constexpr (Sched::AUX_OPS > 0) {
            if (has_next && wid >= 1 && wid <= Sched::AUX_OPS) __builtin_amdgcn_global_load_lds((const unsigned*)(S.aux_ptr(nxt, wid - 1) + lane * 4), (LAS unsigned*)(lds + AUX_LDS_OFF + ((ui + 1) % 3) * AUX_BUF + (wid - 1) * 1024), 16, 0, 0);
        }
#define PG8_TRIP(Z) do { \
            const bool last = (t == ntc - 2); \
            if constexpr (G) { \
                if (last && has_next) { \
                    const LAS int* tl = (const LAS int*)(lds + TOK_LDS_OFF); \
_Pragma("unroll") \
                    for (int h = 0; h < 2; ++h) \
_Pragma("unroll") \
                        for (int i = 0; i < 2; ++i) { const int r = rowA[i] + HALF * h; int id = tl[r]; id = r < ncnt ? id : 0; aoN[h][i] = (unsigned)id * (unsigned)KB + colA[i]; } \
                } else if (last) { \
_Pragma("unroll") \
                    for (int h = 0; h < 2; ++h) \
_Pragma("unroll") \
                        for (int i = 0; i < 2; ++i) aoN[h][i] = aoC[h][i]; \
                } \
            } \
            const char* a1 = cA + (size_t)(t + 1) * kstep; \
            const char* a2 = last ? nA : cA + (size_t)(t + 2) * kstep; const char* b2 = last ? nB : cB + (size_t)(t + 2) * kstep; \
            const char* a3 = a2 + kstep; const char* b3 = b2 + kstep; \
            unsigned o2[2][2]; \
_Pragma("unroll") \
            for (int h = 0; h < 2; ++h) \
_Pragma("unroll") \
                for (int i = 0; i < 2; ++i) o2[h][i] = (G && last) ? aoN[h][i] : aoC[h][i]; \
            PG8_LDB(B0, 0, 0); PG8_LDB(B1, 0, 1); PG8_SCHED; PG8_LDA(At, 0, 0); PG8_STAGE2(PG8_SA(1, 1), a1, aoC[1][0], aoC[1][1]); \
            PG8_WAIT_V(8); PG8_WAIT_L(0); PG8_BAR; PG8_MMA(0, 0, At, B0, Z); PG8_MMA(0, 1, At, B1, Z); PG8_BAR; PG8_SCHED; \
            PG8_LDA(At, 0, 1); PG8_STB(PG8_SB(0, 0), b2); PG8_STB(PG8_SB(0, 1), b2 + hstep); PG8_STAGE2(PG8_SA(0, 0), a2, o2[0][0], o2[0][1]); \
            PG8_WAIT_V(8); PG8_WAIT_L(0); PG8_BAR; PG8_MMA(1, 0, At, B0, Z); PG8_MMA(1, 1, At, B1, Z); PG8_BAR; PG8_SCHED; \
            PG8_LDB(B0, 1, 0); PG8_LDB(B1, 1, 1); PG8_SCHED; PG8_LDA(At, 1, 0); PG8_STAGE2(PG8_SA(0, 1), a2, o2[1][0], o2[1][1]); \
            PG8_WAIT_V(8); PG8_WAIT_L(0); PG8_BAR; PG8_MMA(0, 0, At, B0, 0); PG8_MMA(0, 1, At, B1, 0); PG8_BAR; PG8_SCHED; \
            PG8_LDA(At, 1, 1); PG8_STB(PG8_SB(1, 0), b3); PG8_STB(PG8_SB(1, 1), b3 + hstep); PG8_STAGE2(PG8_SA(1, 0), a3, o2[0][0], o2[0][1]); \
            PG8_WAIT_V(8); PG8_WAIT_L(0); PG8_BAR; PG8_MMA(1, 0, At, B0, 0); PG8_MMA(1, 1, At, B1, 0); PG8_BAR; PG8_SCHED; \
        } while (0)
        if constexpr (Sched::FP8) { int t = 0; PG8_TRIP(1); for (t = 2; t < ntc; t += 2) PG8_TRIP(0); }
        else { for (int t = 0; t < ntc; t += 2) PG8_TRIP(0); }
#undef PG8_TRIP
        if (wr == 0) PG8_BAR;
        E(acc, cur, wr, wc, fr, fq, lds + AUX_LDS_OFF + (ui % 3) * AUX_BUF);
#ifdef EPI_TWICE
        if constexpr (Epi::IDEMPOTENT) { asm volatile("" ::: "memory"); E(acc, cur, wr, wc, fr, fq, lds + AUX_LDS_OFF + (ui % 3) * AUX_BUF); }
#endif
        if (!has_next) break;
        PG8_ZERO_ACC;
        cur = nxt; cA = nA; cB = nB; ++ui;
        if constexpr (G) {
#pragma unroll
            for (int h = 0; h < 2; ++h)
#pragma unroll
                for (int i = 0; i < 2; ++i) aoC[h][i] = aoN[h][i];
        }
        if (wr == 1) PG8_BAR;
    }
    PG8_WAIT_V(0);
    PG8_BAR;
#undef PG8_ZERO_ACC
#undef PG8_SA
#undef PG8_SB
#undef PG8_STAGE2
#undef PG8_STB
#undef PG8_LDA
#undef PG8_LDB
#undef PG8_MMA
#undef PG8_WAIT_V
#undef PG8_WAIT_L
#undef PG8_BAR
#undef PG8_SCHED
}
}
using pg8::Unit;
typedef f32x4 AccT[2][2][4][2];

__device__ __forceinline__ float rstd_from_aux(const LAS unsigned char* aux, int r) {
    const f32x4 a = *((const LAS f32x4*)aux + r); return __builtin_amdgcn_rsqf(((a[0] + a[1]) + (a[2] + a[3])) * (1.0f / D) + EPS);
}
__device__ __forceinline__ float rstd_from_ssp(const float* ssp, int row) {
    const f32x4* p = (const f32x4*)(ssp + (size_t)row * 16); const f32x4 a = p[0], b = p[1], c = p[2], d = p[3];
    const float s = ((a[0] + a[1]) + (a[2] + a[3])) + ((b[0] + b[1]) + (b[2] + b[3])) + ((c[0] + c[1]) + (c[2] + c[3])) + ((d[0] + d[1]) + (d[2] + d[3]));
    return __builtin_amdgcn_rsqf(s * (1.0f / D) + EPS);
}

template <int AUXN, int NN> struct SchedDenseT {
    static constexpr bool GATHER = false, VARK = false, FP8 = false; static constexpr int SCALE_W = 127, SCALE_X = 127, AUX_OPS = AUXN;
    int nM, G, c; const char* A; const char* B; size_t tstep; const float* ssp4;
    __device__ __forceinline__ const float* aux_ptr(const Unit& u, int w) const { return ssp4 + (size_t)u.pm * 1024 + w * 256; }
    __device__ __forceinline__ bool next(int i, Unit& u) const { u.aux = 0; u.kc = -1; u.slab = 0; return pg8::static_order<NN>(nM, G, c, i, u.pm, u.pn); }
    __device__ __forceinline__ const char* a_ptr(const Unit& u) const { return A + (size_t)u.pm * tstep; }
    __device__ __forceinline__ const char* b_ptr(const Unit& u) const { return B + (size_t)u.pn * tstep; }
};

struct MoeTab { const LAS int* ts; const LAS int* cnt; const LAS int* tile; int nM; };
__device__ __forceinline__ int moe_expert_of(const MoeTab& T, int j) { int e = 0;
#pragma unroll
    for (int x = 1; x < 8; ++x) e += (j >= T.ts[x]) ? 1 : 0;
    return e; }

constexpr int MOE_SPLIT = 7, MOE_KC = DFE / MOE_SPLIT;
struct SchedMoeUp {
    static constexpr bool GATHER = true, VARK = false, FP8 = true; static constexpr int SCALE_W = 127 - WEGU_SH, SCALE_X = 127, AUX_OPS = 1, NN = 2 * DFE / 256;
    MoeTab T0, T1; int G, c; const char* A; const char* B; const int* ltok; const float* lrs;
    __device__ __forceinline__ bool next(int i, Unit& u) const {
        const int U0 = T0.nM * NN, U1 = T1.nM * NN; u.kc = -1; u.slab = 0;
        const int v = i * G + c; if (v >= U0 + U1) return false;
        const int k = v >= U0 ? 1 : 0;
        pg8::order_map<NN>(k ? T1.nM : T0.nM, v - (k ? U0 : 0), u.pm, u.pn);
        u.aux = (k << 30) | (k ? T1.tile : T0.tile)[u.pm]; return true; }
    __device__ __forceinline__ const char* a_ptr(const Unit&) const { return A; }
    __device__ __forceinline__ const char* b_ptr(const Unit& u) const { return B + ((size_t)((u.aux >> 16) & 7) * 2 * DFE + (size_t)u.pn * 256) * D; }
    __device__ __forceinline__ const int* list_ptr(const Unit& u) const { return ltok + (size_t)((u.aux >> 30) * 8 + ((u.aux >> 16) & 7)) * LCAP + (u.aux & 0xffff) * 256; }
    __device__ __forceinline__ const float* aux_ptr(const Unit& u, int) const { return lrs + (size_t)((u.aux >> 30) * 8 + ((u.aux >> 16) & 7)) * LCAP + (u.aux & 0xffff) * 256; }
    __device__ __forceinline__ int list_cnt(const Unit& u) const { const MoeTab& T = (u.aux >> 30) ? T1 : T0; const int r = T.cnt[(u.aux >> 16) & 7] - (u.aux & 0xffff) * 256; return r < 256 ? r : 256; }
};
struct SchedMoeDown {
    static constexpr bool GATHER = false, VARK = true, FP8 = true; static constexpr int SCALE_W = 127 - WED_SH, SCALE_X = 127 - ACT_SH, AUX_OPS = 2, NN = D / 256;
    MoeTab T; int G, c, k; const char* A; const char* B; const int* ltok; const float* lgate; int full, lf;
    __device__ __forceinline__ void init() { const int U = T.nM * NN; full = (U / G) * G; lf = U - full; }
    __device__ __forceinline__ bool next(int i, Unit& u) const {
        u.kc = -1; u.slab = 0;
        const int v = i * G + c; int L;
        if (v >= full + lf * MOE_SPLIT) return false;
        if (v < full) L = v; else { const int lo = v - full; L = full + lo / MOE_SPLIT; u.kc = lo % MOE_SPLIT; u.slab = lo; }
        pg8::order_map<NN>(T.nM, L, u.pm, u.pn);
        u.aux = T.tile[u.pm]; return true; }
    __device__ __forceinline__ const float* aux_ptr(const Unit& u, int w) const { const size_t lo = (size_t)(k * 8 + (u.aux >> 16)) * LCAP + (u.aux & 0xffff) * 256; return w ? lgate + lo : (const float*)(ltok + lo); }
    __device__ __forceinline__ int nt_of(const Unit& u) const { return u.kc >= 0 ? MOE_KC / 128 : DFE / 128; }
    __device__ __forceinline__ const char* a_ptr(const Unit& u) const { return A + (size_t)u.pm * 256 * DFE + (u.kc > 0 ? (size_t)u.kc * MOE_KC : 0); }
    __device__ __forceinline__ const char* b_ptr(const Unit& u) const { return B + ((size_t)(u.aux >> 16) * D + (size_t)u.pn * 256) * DFE + (u.kc > 0 ? (size_t)u.kc * MOE_KC : 0); }
};

struct EpiInProj {
    static constexpr bool IDEMPOTENT = true;
    bf16_t* Z; const float* ssp; const LAS float* gt;
    __device__ __forceinline__ void operator()(const AccT& acc, const Unit& u, int wr, int wc, int fr, int fq, const LAS unsigned char* aux) const {
        asm volatile("" : "+v"(fr), "+v"(fq));
        const int T = u.pn;
        int mode = 0; const LAS float* g = gt;
        if (T < 2) { mode = 1; g = gt; } else if (T == 2) { if (wc < 2) { mode = 1; g = gt + 64; } } else if (T == 3) { mode = 2; g = gt + 128; } else if (T == 4) { mode = 2; g = gt + 192; }
        f32x4 gv[2][2];
#pragma unroll
        for (int bj = 0; bj < 2; ++bj)
#pragma unroll
            for (int n = 0; n < 2; ++n) gv[bj][n] = mode == 0 ? (f32x4){1.f, 1.f, 1.f, 1.f} : *(const LAS f32x4*)(g + (mode == 1 ? 32 * bj : 0) + 8 * fq + 4 * n);
        const int row0 = u.pm * 256 + wr * 64 + fr;
        f32x4 qv[2][4];
#pragma unroll
        for (int ai = 0; ai < 2; ++ai)
#pragma unroll
            for (int m = 0; m < 4; ++m) qv[ai][m] = *((const LAS f32x4*)aux + (wr * 64 + fr + ai * 128 + m * 16));
#pragma unroll
        for (int ai = 0; ai < 2; ++ai)
#pragma unroll
            for (int m = 0; m < 4; ++m) {
                const int row = row0 + ai * 128 + m * 16; const f32x4 q4 = qv[ai][m]; const float rs = __builtin_amdgcn_rsqf(((q4[0] + q4[1]) + (q4[2] + q4[3])) * (1.0f / D) + EPS);
                f32x4 v[2][2]; float s0 = 0.f, s1 = 0.f;
#pragma unroll
                for (int n = 0; n < 2; ++n) { v[0][n] = acc[ai][0][m][n] * rs; v[1][n] = acc[ai][1][m][n] * rs;
                    s0 += (v[0][n][0] * v[0][n][0] + v[0][n][1] * v[0][n][1]) + (v[0][n][2] * v[0][n][2] + v[0][n][3] * v[0][n][3]);
                    s1 += (v[1][n][0] * v[1][n][0] + v[1][n][1] * v[1][n][1]) + (v[1][n][2] * v[1][n][2] + v[1][n][3] * v[1][n][3]); }
                float r0 = 1.f, r1 = 1.f;
                if (mode != 0) {
                    s0 = xor32_add(xor16_add(s0)); s1 = xor32_add(xor16_add(s1));
                    if (mode == 1) { r0 = r1 = __builtin_amdgcn_rsqf((s0 + s1) * (1.0f / 64.0f) + EPS); }
                    else { r0 = __builtin_amdgcn_rsqf(s0 * (1.0f / 32.0f) + EPS); r1 = __builtin_amdgcn_rsqf(s1 * (1.0f / 32.0f) + EPS); }
                }
                const int b = row >> 11, t = row & 2047;
                bf16_t* zp = Z + ((size_t)(b * LP + 128 + t)) * DIN + T * 256 + wc * 64 + 8 * fq;
#pragma unroll
                for (int bj = 0; bj < 2; ++bj) { const float rr = bj ? r1 : r0; const f32x4 a = v[bj][0] * gv[bj][0] * rr, c = v[bj][1] * gv[bj][1] * rr;
                    u32x4 w; w.x = cvt_pk_bf16(a[0], a[1]); w.y = cvt_pk_bf16(a[2], a[3]); w.z = cvt_pk_bf16(c[0], c[1]); w.w = cvt_pk_bf16(c[2], c[3]);
                    *(u32x4*)(zp + 32 * bj) = w; }
            }
    }
};

template <int MODE> struct EpiRes {
    static constexpr bool IDEMPOTENT = (MODE == 0);
    const float* res; bf16_t* hb; float* ssp; unsigned char* hb8; LAS float* rowsum;
    __device__ __forceinline__ void operator()(const AccT& acc, const Unit& u, int wr, int wc, int fr, int fq, const LAS unsigned char* aux) const {
        asm volatile("" : "+v"(fr), "+v"(fq));
        const int row0 = u.pm * 256 + wr * 64 + fr, col0 = u.pn * 256 + wc * 32 + 8 * fq;
#pragma unroll
        for (int ai = 0; ai < 2; ++ai) {
            u32x4 hv[4][2];
            if constexpr (MODE != 0) {
#pragma unroll
                for (int m = 0; m < 4; ++m)
#pragma unroll
                    for (int bj = 0; bj < 2; ++bj) hv[m][bj] = *(const u32x4*)(hb + (size_t)(row0 + ai * 128 + m * 16) * D + col0 + bj * 128);
                asm volatile("" ::: "memory");
            }
#pragma unroll
            for (int m = 0; m < 4; ++m) {
                const int row = row0 + ai * 128 + m * 16; const size_t off = (size_t)row * D + col0; float ss = 0.f;
#pragma unroll
                for (int bj = 0; bj < 2; ++bj) {
                    f32x4 a, c;
                    if constexpr (MODE == 0) { a = *(const f32x4*)(res + off + bj * 128); c = *(const f32x4*)(res + off + bj * 128 + 4); }
                    else { const u32x4 h = hv[m][bj]; a = (f32x4){bf16_lo(h.x), bf16_hi(h.x), bf16_lo(h.y), bf16_hi(h.y)}; c = (f32x4){bf16_lo(h.z), bf16_hi(h.z), bf16_lo(h.w), bf16_hi(h.w)}; }
                    a += acc[ai][bj][m][0]; c += acc[ai][bj][m][1];
                    u32x4 w; w.x = cvt_pk_bf16(a[0], a[1]); w.y = cvt_pk_bf16(a[2], a[3]); w.z = cvt_pk_bf16(c[0], c[1]); w.w = cvt_pk_bf16(c[2], c[3]);
                    *(u32x4*)(hb + off + bj * 128) = w;
                    if constexpr (MODE == 2) { u32x2 w8; w8.x = pack4_fp8(a[0], a[1], a[2], a[3]); w8.y = pack4_fp8(c[0], c[1], c[2], c[3]); *(u32x2*)(hb8 + off + bj * 128) = w8; }
                    ss += ((a[0] * a[0] + a[1] * a[1]) + (a[2] * a[2] + a[3] * a[3])) + ((c[0] * c[0] + c[1] * c[1]) + (c[2] * c[2] + c[3] * c[3])); }
                ss = xor32_add(xor16_add(ss));
                if (fq == 0) rowsum[(row - u.pm * 256) * 4 + wc] = ss;
            }
            asm volatile("" ::: "memory");
        }
        asm volatile("s_waitcnt lgkmcnt(0)" ::: "memory"); __builtin_amdgcn_s_barrier(); asm volatile("" ::: "memory");
        if (threadIdx.x < 256) { const f32x4 q = *((const LAS f32x4*)rowsum + threadIdx.x); ssp[(size_t)(u.pm * 256 + threadIdx.x) * 4 + u.pn] = (q[0] + q[1]) + (q[2] + q[3]); }
        asm volatile("s_waitcnt lgkmcnt(0)" ::: "memory"); __builtin_amdgcn_s_barrier(); asm volatile("" ::: "memory");
    }
};

__device__ __forceinline__ f32x4 swiglu4(f32x4 g, f32x4 u, float nrs, float irs2) {
    const f32x4 t = g * nrs; f32x4 e; e[0] = __builtin_amdgcn_exp2f(t[0]); e[1] = __builtin_amdgcn_exp2f(t[1]); e[2] = __builtin_amdgcn_exp2f(t[2]); e[3] = __builtin_amdgcn_exp2f(t[3]);
    const f32x4 d = e * irs2 + irs2; f32x4 r; r[0] = __builtin_amdgcn_rcpf(d[0]); r[1] = __builtin_amdgcn_rcpf(d[1]); r[2] = __builtin_amdgcn_rcpf(d[2]); r[3] = __builtin_amdgcn_rcpf(d[3]);
    return (g * u) * r;
}
__device__ __forceinline__ float silu_mul(float g, float u) { return g * __builtin_amdgcn_rcpf(1.0f + __builtin_amdgcn_exp2f(-g * LOG2E)) * u; }

struct EpiSwiglu {
    static constexpr bool IDEMPOTENT = true;
    bf16_t* act; const float* ssp;
    __device__ __forceinline__ void operator()(const AccT& acc, const Unit& u, int wr, int wc, int fr, int fq, const LAS unsigned char* aux) const {
        asm volatile("" : "+v"(fr), "+v"(fq));
        const int row0 = u.pm * 256 + wr * 64 + fr, col0 = u.pn * 128 + wc * 32 + 8 * fq;
        f32x4 qv[2][4];
#pragma unroll
        for (int ai = 0; ai < 2; ++ai)
#pragma unroll
            for (int m = 0; m < 4; ++m) qv[ai][m] = *((const LAS f32x4*)aux + (wr * 64 + fr + ai * 128 + m * 16));
#pragma unroll
        for (int ai = 0; ai < 2; ++ai)
#pragma unroll
            for (int m = 0; m < 4; ++m) {
                const int row = row0 + ai * 128 + m * 16; const f32x4 q4 = qv[ai][m]; const float rs = __builtin_amdgcn_rsqf(((q4[0] + q4[1]) + (q4[2] + q4[3])) * (1.0f / D) + EPS);
                const float nrs = -rs * LOG2E, irs2 = __builtin_amdgcn_rcpf(rs * rs);
                const f32x4 a0 = swiglu4(acc[ai][0][m][0], acc[ai][1][m][0], nrs, irs2), a1 = swiglu4(acc[ai][0][m][1], acc[ai][1][m][1], nrs, irs2);
                u32x4 w; w.x = cvt_pk_bf16(a0[0], a0[1]); w.y = cvt_pk_bf16(a0[2], a0[3]); w.z = cvt_pk_bf16(a1[0], a1[1]); w.w = cvt_pk_bf16(a1[2], a1[3]);
                __builtin_nontemporal_store(w, (u32x4*)(act + (size_t)row * DFF + col0));
            }
    }
};

struct EpiSwigluMoe {
    static constexpr bool IDEMPOTENT = true;
    unsigned char* act; const float* lrs; MoeTab T0, T1;
    __device__ __forceinline__ void operator()(const AccT& acc, const Unit& u, int wr, int wc, int fr, int fq, const LAS unsigned char* aux) const {
        asm volatile("" : "+v"(fr), "+v"(fq));
        const int k = u.aux >> 30, e = (u.aux >> 16) & 7, lt = u.aux & 0xffff; const MoeTab& T = k ? T1 : T0;
        const LAS float* lp = (const LAS float*)aux; const int cnt = T.cnt[e] - lt * 256;
        const int r0 = wr * 64 + fr, col0 = u.pn * 128 + wc * 32 + 8 * fq; constexpr float SC = (float)(1 << ACT_SH);
        unsigned char* abase = act; asm volatile("" : "+s"(abase));
        unsigned char* ab = abase + (size_t)k * ACTE_BYTES + (size_t)u.pm * 256 * DFE + col0;
        float rsv[2][4];
#pragma unroll
        for (int ai = 0; ai < 2; ++ai)
#pragma unroll
            for (int m = 0; m < 4; ++m) rsv[ai][m] = lp[r0 + ai * 128 + m * 16];
#pragma unroll
        for (int ai = 0; ai < 2; ++ai)
#pragma unroll
            for (int m = 0; m < 4; ++m) {
                const int r = r0 + ai * 128 + m * 16; const float rs = (r < cnt) ? rsv[ai][m] : 0.f;
                const float nrs = -rs * LOG2E, irs2 = __builtin_amdgcn_rcpf(rs * rs * SC);
                const f32x4 a0 = swiglu4(acc[ai][0][m][0], acc[ai][1][m][0], nrs, irs2), a1 = swiglu4(acc[ai][0][m][1], acc[ai][1][m][1], nrs, irs2);
                u32x2 w; w.x = pack4_fp8(a0[0], a0[1], a0[2], a0[3]); w.y = pack4_fp8(a1[0], a1[1], a1[2], a1[3]);
                __builtin_nontemporal_store(w, (u32x2*)(ab + (size_t)r * DFE));
            }
    }
};

template <bool FIRST> struct EpiMoeDown {
    static constexpr bool IDEMPOTENT = false;
    float* out; bf16_t* hb; const int* ltok; const float* lgate; MoeTab T; int k; float* part;
    __device__ __forceinline__ void operator()(const AccT& acc, const Unit& u, int wr, int wc, int fr, int fq, const LAS unsigned char* aux) const {
        asm volatile("" : "+v"(fr), "+v"(fq));
        const int r0 = wr * 64 + fr;
        if (u.kc >= 0) {
            float* pbase = part; asm volatile("" : "+s"(pbase));
            float* pp = pbase + (size_t)u.slab * 65536 + wc * 32 + 8 * fq;
#pragma unroll
            for (int ai = 0; ai < 2; ++ai)
#pragma unroll
                for (int m = 0; m < 4; ++m) { float* rp = pp + (size_t)(r0 + ai * 128 + m * 16) * 256;
#pragma unroll
                    for (int bj = 0; bj < 2; ++bj) { *(f32x4*)(rp + bj * 128) = acc[ai][bj][m][0]; *(f32x4*)(rp + bj * 128 + 4) = acc[ai][bj][m][1]; } }
            return;
        }
        const int e = u.aux >> 16, lt = u.aux & 0xffff; const size_t lo = (size_t)(k * 8 + e) * LCAP + lt * 256; const int cnt = T.cnt[e] - lt * 256;
        const int col0 = u.pn * 256 + wc * 32 + 8 * fq;
#pragma unroll
        for (int ai = 0; ai < 2; ++ai) {
            int tk[4]; float gg[4]; u32x4 hv[4][2];
#pragma unroll
            for (int m = 0; m < 4; ++m) { const int r = r0 + ai * 128 + m * 16; const bool ok = r < cnt; tk[m] = ok ? ((const LAS int*)aux)[r] : 0; gg[m] = ok ? ((const LAS float*)aux)[256 + r] : 0.f; }
#pragma unroll
            for (int m = 0; m < 4; ++m)
#pragma unroll
                for (int bj = 0; bj < 2; ++bj) hv[m][bj] = *(const u32x4*)(hb + (size_t)tk[m] * D + col0 + bj * 128);
            asm volatile("" ::: "memory");
#pragma unroll
            for (int m = 0; m < 4; ++m) {
                const int r = r0 + ai * 128 + m * 16;
                if (r < cnt) { const int tok = tk[m]; const float g = gg[m]; float* op = out + (size_t)tok * D + col0; bf16_t* hp = hb + (size_t)tok * D + col0;
#pragma unroll
                    for (int bj = 0; bj < 2; ++bj) { const u32x4 h = hv[m][bj];
                        const f32x4 a = (f32x4){bf16_lo(h.x), bf16_hi(h.x), bf16_lo(h.y), bf16_hi(h.y)} + acc[ai][bj][m][0] * g, c = (f32x4){bf16_lo(h.z), bf16_hi(h.z), bf16_lo(h.w), bf16_hi(h.w)} + acc[ai][bj][m][1] * g;
                        if constexpr (FIRST) { u32x4 w; w.x = cvt_pk_bf16(a[0], a[1]); w.y = cvt_pk_bf16(a[2], a[3]); w.z = cvt_pk_bf16(c[0], c[1]); w.w = cvt_pk_bf16(c[2], c[3]); *(u32x4*)(hp + bj * 128) = w; }
                        else { *(f32x4*)(op + bj * 128) = a; *(f32x4*)(op + bj * 128 + 4) = c; } } }
            }
            asm volatile("" ::: "memory");
        }
    }
};

template <bool FIRST> __device__ __forceinline__ void moe_reduce(const MoeTab& T, int k, int G, float* out, bf16_t* hb, const int* ltok, const float* lgate, const float* part, int gw, int NGW, int lane) {
    const int nM = T.nM, U = nM * 4, full = (U / G) * G, lf = U - full, total = lf * 256;
    for (int base = gw; base < total; base += 4 * NGW) {
        int tok[4], pnv[4], jv[4], rv[4]; float g[4]; bool ok[4];
#pragma unroll
        for (int i = 0; i < 4; ++i) { const int w = base + i * NGW; ok[i] = w < total; const int ww = ok[i] ? w : base; jv[i] = ww >> 8; rv[i] = ww & 255; int pm; pg8::order_map<4>(nM, full + jv[i], pm, pnv[i]);
            const int tw = T.tile[pm], e = tw >> 16, lt = tw & 0xffff, cnt = T.cnt[e] - lt * 256; ok[i] = ok[i] && rv[i] < cnt;
            const size_t lo = (size_t)(k * 8 + e) * LCAP + lt * 256 + (ok[i] ? rv[i] : 0); tok[i] = ok[i] ? ltok[lo] : 0; g[i] = ok[i] ? lgate[lo] : 0.f; }
        f32x4 s[4]; u32x2 h[4];
#pragma unroll
        for (int i = 0; i < 4; ++i) { s[i] = (f32x4){0.f, 0.f, 0.f, 0.f};
#pragma unroll
            for (int c = 0; c < MOE_SPLIT; ++c) s[i] += *((const f32x4*)(part + (size_t)(jv[i] * MOE_SPLIT + c) * 65536 + (size_t)rv[i] * 256) + lane);
            h[i] = *((const u32x2*)(hb + (size_t)tok[i] * D + pnv[i] * 256) + lane); }
        asm volatile("" ::: "memory");
#pragma unroll
        for (int i = 0; i < 4; ++i) if (ok[i]) {
            const f32x4 v = (f32x4){bf16_lo(h[i].x), bf16_hi(h[i].x), bf16_lo(h[i].y), bf16_hi(h[i].y)} + s[i] * g[i];
            if constexpr (FIRST) { u32x2 w; w.x = cvt_pk_bf16(v[0], v[1]); w.y = cvt_pk_bf16(v[2], v[3]); *((u32x2*)(hb + (size_t)tok[i] * D + pnv[i] * 256) + lane) = w; }
            else *((f32x4*)(out + (size_t)tok[i] * D + pnv[i] * 256) + lane) = v; }
    }
}
__device__ __forceinline__ bool skinny16(LAS unsigned char* lds, const bf16_t* A, const bf16_t* Bt, int K, const int (&rowbase)[4], f32x4 (&acc)[4]) {
    const int tid = threadIdx.x, wid = __builtin_amdgcn_readfirstlane(tid >> 6), lane = tid & 63, fr = lane & 15, kq = lane >> 4;
    const int kw = K / 8, k0 = wid * kw;
#pragma unroll
    for (int cb = 0; cb < 4; ++cb) acc[cb] = (f32x4){0.f, 0.f, 0.f, 0.f};
    const bf16_t* ap = A + (size_t)fr * K + k0 + 8 * kq;
    const bf16_t* bp[4];
#pragma unroll
    for (int cb = 0; cb < 4; ++cb) bp[cb] = Bt + (size_t)(rowbase[cb] + fr) * K + k0 + 8 * kq;
    for (int s0 = 0; s0 < kw; s0 += 128) {
        bf16x8 a[4], b[4][4];
#pragma unroll
        for (int i = 0; i < 4; ++i) { const int s = (s0 + 32 * i < kw) ? s0 + 32 * i : s0; a[i] = *(const bf16x8*)(ap + s);
#pragma unroll
            for (int cb = 0; cb < 4; ++cb) b[i][cb] = *(const bf16x8*)(bp[cb] + s); }
#pragma unroll
        for (int i = 0; i < 4; ++i) if (s0 + 32 * i < kw) {
#pragma unroll
            for (int cb = 0; cb < 4; ++cb) acc[cb] = __builtin_amdgcn_mfma_f32_16x16x32_bf16(b[i][cb], a[i], acc[cb], 0, 0, 0); }
    }
    LAS f32x4* scr = (LAS f32x4*)lds;
#pragma unroll
    for (int cb = 0; cb < 4; ++cb) scr[(wid * 4 + cb) * 64 + lane] = acc[cb];
    __syncthreads();
    if (wid == 0) {
#pragma unroll
        for (int cb = 0; cb < 4; ++cb) { f32x4 s = scr[cb * 64 + lane];
#pragma unroll
            for (int w = 1; w < 8; ++w) s += scr[(w * 4 + cb) * 64 + lane];
            acc[cb] = s; }
    }
    __syncthreads();
    return wid == 0;
}

__device__ __forceinline__ void meta_inproj_unit(LAS unsigned char* lds, int j, const bf16_t* hmb, const bf16_t* win, const float* sspm, const float* gt, bf16_t* Z) {
    const int T = j >> 2, h = j & 3; const int rb[4] = {T * 256 + 32 * h, T * 256 + 32 * h + 16, T * 256 + 128 + 32 * h, T * 256 + 128 + 32 * h + 16};
    f32x4 acc[4];
    if (!skinny16(lds, hmb, win, D, rb, acc)) return;
    const int lane = threadIdx.x & 63, fr = lane & 15, fq = lane >> 4;
    const float rs = rstd_from_ssp(sspm, fr);
    int mode = 0; const float* g = gt;
    if (T < 2) { mode = 1; } else if (T == 2) { if (h < 2) { mode = 1; g = gt + 64; } } else if (T == 3) { mode = 2; g = gt + 128; } else if (T == 4) { mode = 2; g = gt + 192; }
    float s0 = 0.f, s1 = 0.f;
#pragma unroll
    for (int cb = 0; cb < 4; ++cb) { acc[cb] = acc[cb] * rs; const float q = (acc[cb][0] * acc[cb][0] + acc[cb][1] * acc[cb][1]) + (acc[cb][2] * acc[cb][2] + acc[cb][3] * acc[cb][3]); if (cb < 2) s0 += q; else s1 += q; }
    float r0 = 1.f, r1 = 1.f;
    if (mode != 0) {
        s0 = xor32_add(xor16_add(s0)); s1 = xor32_add(xor16_add(s1));
        if (mode == 1) { r0 = r1 = __builtin_amdgcn_rsqf((s0 + s1) * (1.0f / 64.0f) + EPS); }
        else { r0 = __builtin_amdgcn_rsqf(s0 * (1.0f / 32.0f) + EPS); r1 = __builtin_amdgcn_rsqf(s1 * (1.0f / 32.0f) + EPS); }
    }
#pragma unroll
    for (int cb = 0; cb < 4; ++cb) { const int c = cb >> 1, jc = 16 * (cb & 1) + 4 * fq;
        f32x4 v = acc[cb] * (c ? r1 : r0);
        if (mode != 0) v = v * *(const f32x4*)(g + (mode == 1 ? 32 * c : 0) + jc);
        u32x2 w; w.x = cvt_pk_bf16(v[0], v[1]); w.y = cvt_pk_bf16(v[2], v[3]);
        for (int b = 0; b < NBATCH; ++b) *(u32x2*)(Z + ((size_t)(b * LP + PADP + fr)) * DIN + T * 256 + 64 * h + 32 * c + jc) = w; }
}

__device__ __forceinline__ void meta_res_unit(LAS unsigned char* lds, int j, const bf16_t* A, const bf16_t* Bt, int K, float* hm, bf16_t* hmb, float* sspm) {
    const int rb[4] = {64 * j, 64 * j + 16, 64 * j + 32, 64 * j + 48};
    f32x4 acc[4];
    if (!skinny16(lds, A, Bt, K, rb, acc)) return;
    const int lane = threadIdx.x & 63, fr = lane & 15, fq = lane >> 4; float ss = 0.f;
#pragma unroll
    for (int cb = 0; cb < 4; ++cb) { const size_t off = (size_t)fr * D + 64 * j + 16 * cb + 4 * fq; const f32x4 v = *(const f32x4*)(hm + off) + acc[cb];
        *(f32x4*)(hm + off) = v; u32x2 w; w.x = cvt_pk_bf16(v[0], v[1]); w.y = cvt_pk_bf16(v[2], v[3]); *(u32x2*)(hmb + off) = w;
        ss += (v[0] * v[0] + v[1] * v[1]) + (v[2] * v[2] + v[3] * v[3]); }
    ss = xor32_add(xor16_add(ss));
    if (fq == 0) sspm[fr * 16 + j] = ss;
}

__device__ __forceinline__ void meta_ffnup_unit(LAS unsigned char* lds, int j, const bf16_t* hmb, const bf16_t* wgu, const float* sspm, bf16_t* actm) {
    const int T = j >> 2, h = j & 3; const int rb[4] = {T * 256 + 32 * h, T * 256 + 32 * h + 16, T * 256 + 128 + 32 * h, T * 256 + 128 + 32 * h + 16};
    f32x4 acc[4];
    if (!skinny16(lds, hmb, wgu, D, rb, acc)) return;
    const int lane = threadIdx.x & 63, fr = lane & 15, fq = lane >> 4;
    const float rs = rstd_from_ssp(sspm, fr);
#pragma unroll
    for (int cb = 0; cb < 2; ++cb) { const f32x4 g = acc[cb] * rs, u = acc[cb + 2] * rs;
        u32x2 w; w.x = cvt_pk_bf16(silu_mul(g[0], u[0]), silu_mul(g[1], u[1])); w.y = cvt_pk_bf16(silu_mul(g[2], u[2]), silu_mul(g[3], u[3]));
        *(u32x2*)(actm + (size_t)fr * DFF + 32 * j + 16 * cb + 4 * fq) = w; }
}
__device__ __forceinline__ int crow(int r, int hi) { return (r & 3) + 8 * (r >> 2) + 4 * hi; }
typedef short v4i16_t __attribute__((ext_vector_type(4)));
__device__ __forceinline__ s16x4 vtr(const LAS unsigned char* p) { return __builtin_bit_cast(s16x4, __builtin_amdgcn_ds_read_tr16_b64_v4i16((LAS v4i16_t*)p)); }

__device__ __forceinline__ bf16_t* mix_row(bf16_t* mix, bf16_t* mixm, int b, int pp) {
    if (pp >= 128) return mix + ((size_t)b * SEQ + (pp - 128)) * D;
    if (pp >= PADP && b == 0) return mixm + (size_t)(pp - PADP) * D;
    return nullptr;
}

__device__ __forceinline__ void softmax_step(f32x16& s0, f32x16& s1, float& m_run, float& l_run, f32x16 (&o)[2], LAS float* wsf, int r32, int hi) {
    float mx = s0[0];
#pragma unroll
    for (int r = 1; r < 16; ++r) mx = fmaxf(mx, s0[r]);
#pragma unroll
    for (int r = 0; r < 16; ++r) mx = fmaxf(mx, s1[r]);
    mx = xor32_max(mx);
    const float mn = fmaxf(m_run, mx), f = __builtin_amdgcn_exp2f(m_run - mn);
    m_run = mn;
    float sum = 0.f;
#pragma unroll
    for (int r = 0; r < 16; ++r) { s0[r] = __builtin_amdgcn_exp2f(s0[r] - mn); s1[r] = __builtin_amdgcn_exp2f(s1[r] - mn); sum += s0[r] + s1[r]; }
    l_run = l_run * f + sum;
    if (hi == 0) wsf[r32] = f;
    LDS_WAIT();
#pragma unroll
    for (int r = 0; r < 16; ++r) { const float fo = wsf[crow(r, hi)]; o[0][r] *= fo; o[1][r] *= fo; }
    LDS_WAIT();
}
__device__ __forceinline__ float max3(float a, float b, float c) { float r; asm("v_max3_f32 %0, %1, %2, %3" : "=v"(r) : "v"(a), "v"(b), "v"(c)); return r; }
__device__ __forceinline__ bf16x8 ones_frag() { u32x4 w; asm volatile("v_mov_b32 %0, 0x3f803f80\n\tv_mov_b32 %1, 0x3f803f80\n\tv_mov_b32 %2, 0x3f803f80\n\tv_mov_b32 %3, 0x3f803f80" : "=v"(w.x), "=v"(w.y), "=v"(w.z), "=v"(w.w)); return __builtin_bit_cast(bf16x8, w); }
__device__ __forceinline__ void rowsum_step(f32x16& l, const bf16x8 (&pa)[4], const bf16x8& ones) {
#pragma unroll
    for (int s = 0; s < 4; ++s) l = __builtin_amdgcn_mfma_f32_32x32x16_bf16(pa[s], ones, l, 0, 0, 0);
}
__device__ __forceinline__ void pack_p(const f32x16& s0, const f32x16& s1, bf16x8 (&pa)[4]) {
#pragma unroll
    for (int s = 0; s < 4; ++s) { const f32x16& p = (s < 2) ? s0 : s1; const int b = 8 * (s & 1);
        u32x4 w; w.x = cvt_pk_bf16(p[b], p[b + 1]); w.y = cvt_pk_bf16(p[b + 2], p[b + 3]); w.z = cvt_pk_bf16(p[b + 4], p[b + 5]); w.w = cvt_pk_bf16(p[b + 6], p[b + 7]);
        pa[s] = __builtin_bit_cast(bf16x8, w); }
}
__device__ __forceinline__ void pv_step(f32x16 (&o)[2], const bf16x8 (&pa)[4], const LAS unsigned char* vbase, int half_stride, int lane) {
    const int hi = lane >> 5; const LAS unsigned char* vp = vbase + (4 * hi + ((lane & 15) >> 2)) * 64 + ((lane >> 4) & 1) * 32 + (lane & 3) * 8;
#pragma unroll
    for (int d0 = 0; d0 < 2; ++d0)
#pragma unroll
        for (int s = 0; s < 4; ++s) { const s16x4 lo = vtr(vp + d0 * half_stride + s * 1024), hh = vtr(vp + d0 * half_stride + s * 1024 + 512);
            const bf16x8 vf = (bf16x8){lo[0], lo[1], lo[2], lo[3], hh[0], hh[1], hh[2], hh[3]};
            o[d0] = __builtin_amdgcn_mfma_f32_32x32x16_bf16(pa[s], vf, o[d0], 0, 0, 0); }
}

__device__ __forceinline__ void v_frags_asm(bf16x8 (&vf)[2][4], const LAS unsigned char* vbase, int lane) {
    const int hi = lane >> 5; const unsigned vp = (unsigned)(size_t)(vbase + (4 * hi + ((lane & 15) >> 2)) * 64 + ((lane >> 4) & 1) * 32 + (lane & 3) * 8);
    u32x2 r[16];
    asm volatile(
        "ds_read_b64_tr_b16 %0, %16\n\tds_read_b64_tr_b16 %1, %16 offset:512\n\tds_read_b64_tr_b16 %2, %16 offset:1024\n\tds_read_b64_tr_b16 %3, %16 offset:1536\n\t"
        "ds_read_b64_tr_b16 %4, %16 offset:2048\n\tds_read_b64_tr_b16 %5, %16 offset:2560\n\tds_read_b64_tr_b16 %6, %16 offset:3072\n\tds_read_b64_tr_b16 %7, %16 offset:3584\n\t"
        "ds_read_b64_tr_b16 %8, %16 offset:4096\n\tds_read_b64_tr_b16 %9, %16 offset:4608\n\tds_read_b64_tr_b16 %10, %16 offset:5120\n\tds_read_b64_tr_b16 %11, %16 offset:5632\n\t"
        "ds_read_b64_tr_b16 %12, %16 offset:6144\n\tds_read_b64_tr_b16 %13, %16 offset:6656\n\tds_read_b64_tr_b16 %14, %16 offset:7168\n\tds_read_b64_tr_b16 %15, %16 offset:7680\n\t"
        "s_waitcnt lgkmcnt(0)"
        : "=&v"(r[0]), "=&v"(r[1]), "=&v"(r[2]), "=&v"(r[3]), "=&v"(r[4]), "=&v"(r[5]), "=&v"(r[6]), "=&v"(r[7]), "=&v"(r[8]), "=&v"(r[9]), "=&v"(r[10]), "=&v"(r[11]), "=&v"(r[12]), "=&v"(r[13]), "=&v"(r[14]), "=&v"(r[15])
        : "v"(vp) : "memory");
#pragma unroll
    for (int d0 = 0; d0 < 2; ++d0)
#pragma unroll
        for (int s = 0; s < 4; ++s) { const u32x2 lo = r[d0 * 8 + s * 2], hh = r[d0 * 8 + s * 2 + 1]; const u32x4 w = (u32x4){lo.x, lo.y, hh.x, hh.y}; vf[d0][s] = __builtin_bit_cast(bf16x8, w); }
}
__device__ __forceinline__ void v_frags(bf16x8 (&vf)[2][4], const LAS unsigned char* vbase, int half_stride, int lane) {
    const int hi = lane >> 5; const LAS unsigned char* vp = vbase + (4 * hi + ((lane & 15) >> 2)) * 64 + ((lane >> 4) & 1) * 32 + (lane & 3) * 8;
#pragma unroll
    for (int d0 = 0; d0 < 2; ++d0)
#pragma unroll
        for (int s = 0; s < 4; ++s) { const s16x4 lo = vtr(vp + d0 * half_stride + s * 1024), hh = vtr(vp + d0 * half_stride + s * 1024 + 512);
            vf[d0][s] = (bf16x8){lo[0], lo[1], lo[2], lo[3], hh[0], hh[1], hh[2], hh[3]}; }
}
__device__ __forceinline__ void pv_from(f32x16 (&o)[2], const bf16x8 (&pa)[4], const bf16x8 (&vf)[2][4]) {
#pragma unroll
    for (int d0 = 0; d0 < 2; ++d0)
#pragma unroll
        for (int s = 0; s < 4; ++s) o[d0] = __builtin_amdgcn_mfma_f32_32x32x16_bf16(pa[s], vf[d0][s], o[d0], 0, 0, 0);
}

constexpr int AL_V = 0, AL_K = 2 * 256 * 64, AL_LUT = AL_K + 256 * 144, AL_EXT = AL_LUT + 4 * 128 * 4, AL_WS = AL_EXT + 4 * 256 * 4, AL_ST = AL_WS + 8 * 256, AL_END = AL_ST + 8 * 4096;
__device__ __forceinline__ void attnA_unit(LAS unsigned char* lds, int b, int kvh, int ib, const bf16_t* Z, bf16_t* mix, bf16_t* mixm, const float* lutA, const float* sinks) {
    const int tid = threadIdx.x, lane = tid & 63, wid = __builtin_amdgcn_readfirstlane(tid >> 6), r32 = lane & 31, hi = lane >> 5;
    if (wid >= 4) __builtin_amdgcn_s_setprio(1);
    const int kp0 = 128 * (ib - 1);
    const bf16_t* Zb = Z + (size_t)b * LP * DIN;
#pragma unroll
    for (int it = 0; it < 4; ++it) { const int idx = tid + 512 * it, row = idx >> 3, ch = idx & 7, kpp = kp0 + row;
        u32x4 kv = (u32x4){0u, 0u, 0u, 0u}, vv = kv;
        if (kpp >= 0) { const bf16_t* src = Zb + (size_t)kpp * DIN + 64 * kvh + 8 * ch; kv = *(const u32x4*)(src + ZKA); vv = *(const u32x4*)(src + ZVA); }
        *(LAS u32x4*)(lds + AL_K + row * 144 + ch * 16) = kv;
        *(LAS u32x4*)(lds + AL_V + (ch >> 2) * (256 * 64) + row * 64 + (ch & 3) * 16) = vv; }
    ((LAS float*)(lds + AL_LUT))[tid] = lutA[(4 * kvh + (tid >> 7)) * 128 + (tid & 127)];
    const bool fast = ib >= 2;
    if (fast) {
#pragma unroll
        for (int it = 0; it < 2; ++it) { const int idx = tid + 512 * it, hh = idx >> 8, n = (idx & 255) - 64;
            ((LAS float*)(lds + AL_EXT))[idx] = ((unsigned)n < 128u) ? lutA[(4 * kvh + hh) * 128 + n] - sinks[4 * kvh + hh] * LOG2E : NEGF; }
    }
    __syncthreads();
    const int hl = wid >> 1, hq = 4 * kvh + hl;
    LAS float* wsf = (LAS float*)(lds + AL_WS) + wid * 64;
    const LAS float* lut = (const LAS float*)(lds + AL_LUT) + hl * 128;
    const LAS float* ext = (const LAS float*)(lds + AL_EXT) + hl * 256 + (133 + r32 - 4 * hi);
    const float sink2 = sinks[hq] * LOG2E;
#pragma unroll 1
    for (int sub = 0; sub < 2; ++sub) {
        const int qs = 128 * ib + 64 * (wid & 1) + 32 * sub, qpp = qs + r32;
        bf16x8 qr[4];
#pragma unroll
        for (int ks = 0; ks < 4; ++ks) qr[ks] = *(const bf16x8*)(Zb + (size_t)qpp * DIN + ZQA + 64 * hq + 16 * ks + 8 * hi);
        float m_run = NEGF, l_run = 0.f; f32x16 o[2]; o[0] = (f32x16){}; o[1] = (f32x16){};
        if (fast) {
            float m_off = 0.f;
#pragma unroll 1
            for (int jt = 0; jt < 3; ++jt) {
                const int kt = (wid & 1) + jt;
                const LAS float* ep = ext + (32 * sub - 64 * jt);
                f32x16 s0, s1;
#pragma unroll
                for (int r = 0; r < 16; ++r) { const int cr = (r & 3) + 8 * (r >> 2); s0[r] = ep[59 - cr]; s1[r] = ep[27 - cr]; }
                const LAS unsigned char* kb = lds + AL_K + (64 * kt + r32) * 144 + 16 * hi;
                bf16x8 kf0[4], kf1[4];
#pragma unroll
                for (int ks = 0; ks < 4; ++ks) { kf0[ks] = *(const LAS bf16x8*)(kb + ks * 32); kf1[ks] = *(const LAS bf16x8*)(kb + 32 * 144 + ks * 32); }
#pragma unroll
                for (int ks = 0; ks < 4; ++ks) { s0 = __builtin_amdgcn_mfma_f32_32x32x16_bf16(kf0[ks], qr[ks], s0, 0, 0, 0); s1 = __builtin_amdgcn_mfma_f32_32x32x16_bf16(kf1[ks], qr[ks], s1, 0, 0, 0); }
                bf16x8 vfa[2][4]; v_frags(vfa, lds + AL_V + (64 * kt) * 64, 256 * 64, lane);
                float mx = fmaxf(s0[0], s1[0]);
#pragma unroll
                for (int r = 1; r < 16; ++r) mx = fmaxf(mx, fmaxf(s0[r], s1[r]));
                mx = xor32_max(mx);
                if (__any(mx > m_off + 8.0f)) {
                    const float no = fmaxf(m_off, mx), f = __builtin_amdgcn_exp2f(m_off - no); m_off = no; l_run *= f;
                    if (hi == 0) wsf[r32] = f;
                    LDS_WAIT();
#pragma unroll
                    for (int r = 0; r < 16; ++r) { const float fo = wsf[crow(r, hi)]; o[0][r] *= fo; o[1][r] *= fo; }
                    LDS_WAIT();
                }
                if (__any(m_off != 0.f)) {
#pragma unroll
                    for (int r = 0; r < 16; ++r) { s0[r] -= m_off; s1[r] -= m_off; }
                }
                float sum = 0.f;
#pragma unroll
                for (int r = 0; r < 16; ++r) { s0[r] = __builtin_amdgcn_exp2f(s0[r]); s1[r] = __builtin_amdgcn_exp2f(s1[r]); sum += s0[r] + s1[r]; }
                l_run += sum;
                bf16x8 pa[4]; pack_p(s0, s1, pa);
#pragma unroll
                for (int s2 = 0; s2 < 4; ++s2) { o[0] = __builtin_amdgcn_mfma_f32_32x32x16_bf16(pa[s2], vfa[0][s2], o[0], 0, 0, 0); o[1] = __builtin_amdgcn_mfma_f32_32x32x16_bf16(pa[s2], vfa[1][s2], o[1], 0, 0, 0); }
            }
            m_run = sink2 + m_off;
        } else
#pragma unroll 1
        for (int jt = 0; jt < 3; ++jt) {
            const int kt = (wid & 1) + jt, kpp0 = kp0 + 64 * kt;
            f32x16 s0 = (f32x16){}, s1 = (f32x16){};
            const LAS unsigned char* kb = lds + AL_K + (64 * kt + r32) * 144 + 16 * hi;
#pragma unroll
            for (int ks = 0; ks < 4; ++ks) { const bf16x8 k0 = *(const LAS bf16x8*)(kb + ks * 32), k1 = *(const LAS bf16x8*)(kb + 32 * 144 + ks * 32);
                s0 = __builtin_amdgcn_mfma_f32_32x32x16_bf16(k0, qr[ks], s0, 0, 0, 0); s1 = __builtin_amdgcn_mfma_f32_32x32x16_bf16(k1, qr[ks], s1, 0, 0, 0); }
#pragma unroll
            for (int r = 0; r < 16; ++r) { const int kpp = kpp0 + crow(r, hi), n0 = qpp - kpp, n1 = n0 - 32;
                const bool v0 = ((unsigned)n0 < 128u) && (kpp >= PADP), v1 = ((unsigned)n1 < 128u) && (kpp + 32 >= PADP);
                s0[r] = v0 ? s0[r] + lut[n0 & 127] : NEGF; s1[r] = v1 ? s1[r] + lut[n1 & 127] : NEGF; }
            softmax_step(s0, s1, m_run, l_run, o, wsf, r32, hi);
            bf16x8 pa[4]; pack_p(s0, s1, pa);
            pv_step(o, pa, lds + AL_V + (64 * kt) * 64, 256 * 64, lane);
        }
        float lt = xor32_add(l_run); lt += __builtin_amdgcn_exp2f(sink2 - m_run);
        if (hi == 0) wsf[r32] = __builtin_amdgcn_rcpf(lt);
        LDS_WAIT();
#ifdef A_DIRECT_STORE
#pragma unroll
        for (int r = 0; r < 16; ++r) { const int q = crow(r, hi); const float inv = wsf[q]; bf16_t* orow = mix_row(mix, mixm, b, qs + q);
            if (orow) { orow[64 * hq + r32] = (bf16_t)(cvt_pk_bf16(o[0][r] * inv, 0.f) & 0xffffu); orow[64 * hq + 32 + r32] = (bf16_t)(cvt_pk_bf16(o[1][r] * inv, 0.f) & 0xffffu); } }
        LDS_WAIT();
#else
        LAS bf16_t* stg = (LAS bf16_t*)(lds + AL_ST) + wid * 2048;
#pragma unroll
        for (int r = 0; r < 16; ++r) { const int q = crow(r, hi); const float inv = wsf[q];
            stg[q * 64 + r32] = (bf16_t)(cvt_pk_bf16(o[0][r] * inv, 0.f) & 0xffffu); stg[q * 64 + 32 + r32] = (bf16_t)(cvt_pk_bf16(o[1][r] * inv, 0.f) & 0xffffu); }
        LDS_WAIT();
#pragma unroll
        for (int i = 0; i < 4; ++i) { const int row = i * 8 + (lane >> 3), ch = lane & 7; const u32x4 v = *(const LAS u32x4*)(stg + row * 64 + ch * 8);
            bf16_t* orow = mix_row(mix, mixm, b, qs + row); if (orow) *(u32x4*)(orow + 64 * hq + 8 * ch) = v; }
        LDS_WAIT();
#endif
    }
    __builtin_amdgcn_s_setprio(0);
    __syncthreads();
}

constexpr int B2_RING = 0, B2_BT = 3 * 16384, B2_LUT = B2_BT + 7 * 4096, B2_WS = B2_LUT + 512, B2_X = B2_WS + 8 * 256, BL_END = B2_X + 4 * 32 * 68 * 4;
__device__ __forceinline__ void attnB_unit(LAS unsigned char* lds, int b, int h, int ib, const bf16_t* Z, bf16_t* mix, bf16_t* mixm, const float* lutB, const float* bt, bool bt_load, float& cfar_keep, bool chk, float lam, float one_m_lam_init, const float* gout) {
    const int tid = threadIdx.x, lane = tid & 63, wid = __builtin_amdgcn_readfirstlane(tid >> 6), r32 = lane & 31, hi = lane >> 5;
    if (wid >= 4) __builtin_amdgcn_s_setprio(1);
    const bf16_t* Zb = Z + (size_t)b * LP * DIN;
    const int KT_END = 2 * (ib + 1);
    const bf16x8 ones = ones_frag();
    const int c = wid >> 2, wq = wid & 3, qs = 128 * ib + 32 * wq, qpp = qs + r32;
    if (bt_load) {
#pragma unroll
        for (int i = 0; i < 4; ++i) { const int pc = wid + 8 * i; if (pc < 28) __builtin_amdgcn_global_load_lds((const unsigned*)(bt + h * 7168 + pc * 256 + lane * 4), (LAS unsigned*)(lds + B2_BT + pc * 1024), 16, 0, 0); }
    }
    const bf16_t* ksrc = Zb + (size_t)lane * DIN + ZKB + 64 * h + 8 * wid;
    const bf16_t* vsrc = Zb + (size_t)(16 * (wid & 3) + (lane >> 2)) * DIN + ZVB + 64 * h + 32 * (wid >> 2) + 8 * (lane & 3);
#define B_DMA(t, slot) do { __builtin_amdgcn_global_load_lds((const unsigned*)(ksrc + (size_t)(64 * (t)) * DIN), (LAS unsigned*)(lds + B2_RING + (slot) * 16384 + wid * 1024), 16, 0, 0); \
                            __builtin_amdgcn_global_load_lds((const unsigned*)(vsrc + (size_t)(64 * (t)) * DIN), (LAS unsigned*)(lds + B2_RING + (slot) * 16384 + 8192 + wid * 1024), 16, 0, 0); } while (0)
    B_DMA(1, 0);
    if (2 < KT_END) B_DMA(2, 1);
    bf16x8 qr[2];
#pragma unroll
    for (int ks = 0; ks < 2; ++ks) qr[ks] = *(const bf16x8*)(Zb + (size_t)qpp * DIN + ZQB + 64 * h + 32 * c + 16 * ks + 8 * hi);
    const float* lg = lutB + h * 128;
    if (bt_load) { cfar_keep = lg[127]; if (tid < 128) ((LAS float*)(lds + B2_LUT))[tid] = lg[tid]; }
    const float cfar = cfar_keep;
    LAS float* wsf = (LAS float*)(lds + B2_WS) + wid * 64;
    const LAS float* lut = (const LAS float*)(lds + B2_LUT);
    float mref = 0.f; f32x16 o[2], lsum; o[0] = (f32x16){}; o[1] = (f32x16){}; lsum = (f32x16){};
    f32x16 negm;
#pragma unroll
    for (int r = 0; r < 16; ++r) negm[r] = cfar;
    int slot = 0;
    for (int t = 1; t < KT_END; ++t) {
        if (t + 1 < KT_END) asm volatile("s_waitcnt vmcnt(2)" ::: "memory"); else asm volatile("s_waitcnt vmcnt(0)" ::: "memory");
        asm volatile("s_waitcnt lgkmcnt(0)" ::: "memory");
        __builtin_amdgcn_s_barrier();
        asm volatile("" ::: "memory");
        const int kpp0 = 64 * t;
        const bool late_dma = (t == 1) && (kpp0 <= qs + 31);
        if (!late_dma && t + 2 < KT_END) { const int s2 = slot == 0 ? 2 : slot - 1; B_DMA(t + 2, s2); }
        if (kpp0 <= qs + 31) {
            const LAS unsigned char* kb = lds + B2_RING + slot * 16384 + (4 * c + hi) * 1024 + r32 * 16;
            const bf16x8 k00 = *(const LAS bf16x8*)(kb), k01 = *(const LAS bf16x8*)(kb + 2048), k10 = *(const LAS bf16x8*)(kb + 512), k11 = *(const LAS bf16x8*)(kb + 2048 + 512);
            f32x16 s0, s1; bool resc = false; float delta = 0.f;
            bf16x8 vfr[2][4];
            if (t == 1) {
                s0 = (f32x16){}; s1 = (f32x16){};
                s0 = __builtin_amdgcn_mfma_f32_32x32x16_bf16(k00, qr[0], s0, 0, 0, 0); s1 = __builtin_amdgcn_mfma_f32_32x32x16_bf16(k10, qr[0], s1, 0, 0, 0);
                s0 = __builtin_amdgcn_mfma_f32_32x32x16_bf16(k01, qr[1], s0, 0, 0, 0); s1 = __builtin_amdgcn_mfma_f32_32x32x16_bf16(k11, qr[1], s1, 0, 0, 0);
                v_frags_asm(vfr, lds + B2_RING + slot * 16384 + 8192, lane); asm volatile("" :: "v"(k00), "v"(k01), "v"(k10), "v"(k11));
                float mx = NEGF;
#pragma unroll
                for (int r = 0; r < 16; ++r) { const int kpp = kpp0 + crow(r, hi), n0 = qpp - kpp, n1 = n0 - 32;
                    const bool v0 = (n0 >= 0) && (kpp >= PADP), v1 = (n1 >= 0) && (kpp + 32 >= PADP);
                    s0[r] = v0 ? s0[r] + lut[n0 > 127 ? 127 : (n0 & 127)] : NEGF; s1[r] = v1 ? s1[r] + lut[n1 > 127 ? 127 : (n1 & 127)] : NEGF; mx = fmaxf(mx, fmaxf(s0[r], s1[r])); }
                asm volatile("" ::: "memory");
                if (t + 2 < KT_END) { const int s2 = slot == 0 ? 2 : slot - 1; B_DMA(t + 2, s2); }
                mx = xor32_max(mx);
                mref = mx;
#pragma unroll
                for (int r = 0; r < 16; ++r) { s0[r] -= mx; s1[r] -= mx; negm[r] = cfar - mx; }
            } else {
                const int d0 = qs - kpp0;
                if (d0 >= 192) {
                    s0 = __builtin_amdgcn_mfma_f32_32x32x16_bf16(k00, qr[0], negm, 0, 0, 0); s1 = __builtin_amdgcn_mfma_f32_32x32x16_bf16(k10, qr[0], negm, 0, 0, 0);
                    s0 = __builtin_amdgcn_mfma_f32_32x32x16_bf16(k01, qr[1], s0, 0, 0, 0); s1 = __builtin_amdgcn_mfma_f32_32x32x16_bf16(k11, qr[1], s1, 0, 0, 0);
                    v_frags_asm(vfr, lds + B2_RING + slot * 16384 + 8192, lane); asm volatile("" :: "v"(k00), "v"(k01), "v"(k10), "v"(k11));
                } else {
                    const int j0 = (d0 >> 5) + 1, j1 = j0 - 1;
                    const LAS f32x4* t0 = (const LAS f32x4*)(lds + B2_BT) + j0 * 256 + lane; const LAS f32x4* t1 = (const LAS f32x4*)(lds + B2_BT) + j1 * 256 + lane;
#pragma unroll
                    for (int g = 0; g < 4; ++g) { const f32x4 a = t0[g * 64], bq = t1[g * 64]; s0[4 * g] = a[0]; s0[4 * g + 1] = a[1]; s0[4 * g + 2] = a[2]; s0[4 * g + 3] = a[3]; s1[4 * g] = bq[0]; s1[4 * g + 1] = bq[1]; s1[4 * g + 2] = bq[2]; s1[4 * g + 3] = bq[3]; }
                    s0 = __builtin_amdgcn_mfma_f32_32x32x16_bf16(k00, qr[0], s0, 0, 0, 0); s1 = __builtin_amdgcn_mfma_f32_32x32x16_bf16(k10, qr[0], s1, 0, 0, 0);
                    s0 = __builtin_amdgcn_mfma_f32_32x32x16_bf16(k01, qr[1], s0, 0, 0, 0); s1 = __builtin_amdgcn_mfma_f32_32x32x16_bf16(k11, qr[1], s1, 0, 0, 0);
                    v_frags_asm(vfr, lds + B2_RING + slot * 16384 + 8192, lane); asm volatile("" :: "v"(k00), "v"(k01), "v"(k10), "v"(k11));
#pragma unroll
                    for (int r = 0; r < 16; ++r) { s0[r] -= mref; s1[r] -= mref; }
                }
                if (chk) {
                    float mx = fmaxf(s0[0], s1[0]);
#pragma unroll
                    for (int r = 1; r < 16; ++r) mx = max3(mx, s0[r], s1[r]);
                    mx = xor32_max(mx);
                    if (__any(mx > 8.0f)) {
                        delta = fmaxf(mx, 0.f); mref += delta; resc = true;
#pragma unroll
                        for (int r = 0; r < 16; ++r) { s0[r] -= delta; s1[r] -= delta; negm[r] = cfar - mref; }
                    }
                }
            }
#pragma unroll
            for (int r = 0; r < 16; ++r) { s0[r] = __builtin_amdgcn_exp2f(s0[r]); s1[r] = __builtin_amdgcn_exp2f(s1[r]); }
            if (resc) {
                const float f = __builtin_amdgcn_exp2f(-delta);
                if (hi == 0) wsf[r32] = f;
                LDS_WAIT();
#pragma unroll
                for (int r = 0; r < 16; ++r) { const float fo = wsf[crow(r, hi)]; o[0][r] *= fo; o[1][r] *= fo; lsum[r] *= fo; }
                LDS_WAIT();
            }
            bf16x8 pa[4]; pack_p(s0, s1, pa);
#pragma unroll
            for (int s2 = 0; s2 < 4; ++s2) { o[0] = __builtin_amdgcn_mfma_f32_32x32x16_bf16(pa[s2], vfr[0][s2], o[0], 0, 0, 0); o[1] = __builtin_amdgcn_mfma_f32_32x32x16_bf16(pa[s2], vfr[1][s2], o[1], 0, 0, 0); lsum = __builtin_amdgcn_mfma_f32_32x32x16_bf16(pa[s2], ones, lsum, 0, 0, 0); }
        }
        slot = slot == 2 ? 0 : slot + 1;
    }
#undef B_DMA
    LAS float* X = (LAS float*)(lds + B2_X) + wq * (32 * 68);
#pragma unroll
    for (int r = 0; r < 16; ++r) { const float inv = __builtin_amdgcn_rcpf(lsum[r]); o[0][r] *= inv; o[1][r] *= inv; }
    if (c == 1) {
#pragma unroll
        for (int r = 0; r < 16; ++r) { const int q = crow(r, hi); X[q * 68 + r32] = o[0][r]; X[q * 68 + 32 + r32] = o[1][r]; }
    }
    __syncthreads();
    if (c == 0) {
#pragma unroll
        for (int r = 0; r < 16; ++r) { const int q = crow(r, hi); X[q * 68 + r32] = o[0][r] - lam * X[q * 68 + r32]; X[q * 68 + 32 + r32] = o[1][r] - lam * X[q * 68 + 32 + r32]; }
        LDS_WAIT();
        const int q = lane >> 1, hf = lane & 1; f32x4 v[8]; float ss = 0.f;
#pragma unroll
        for (int i = 0; i < 8; ++i) { v[i] = *(const LAS f32x4*)(X + q * 68 + 32 * hf + 4 * i); ss += (v[i][0] * v[i][0] + v[i][1] * v[i][1]) + (v[i][2] * v[i][2] + v[i][3] * v[i][3]); }
        ss += __shfl_xor(ss, 1);
        const float rs = __builtin_amdgcn_rsqf(ss * (1.0f / 64.0f) + EPS) * one_m_lam_init;
        bf16_t* orow = mix_row(mix, mixm, b, qs + q);
#pragma unroll
        for (int i = 0; i < 4; ++i) { const f32x4 g0 = *(const f32x4*)(gout + 32 * hf + 8 * i), g1 = *(const f32x4*)(gout + 32 * hf + 8 * i + 4); const f32x4 a = v[2 * i] * g0 * rs, d = v[2 * i + 1] * g1 * rs;
            u32x4 w; w.x = cvt_pk_bf16(a[0], a[1]); w.y = cvt_pk_bf16(a[2], a[3]); w.z = cvt_pk_bf16(d[0], d[1]); w.w = cvt_pk_bf16(d[2], d[3]);
            if (orow) *(u32x4*)(orow + 512 + 64 * h + 32 * hf + 8 * i) = w; }
    }
    __builtin_amdgcn_s_setprio(0);
    __syncthreads();
}

constexpr int CL_U = 0, CL_D = 80 * 528, CL_END = CL_D + 64 * 528;
__device__ __forceinline__ void pool_unit(LAS unsigned char* lds, int b, int jb, const bf16_t* Z, bf16_t* mix, bf16_t* mixm, const bf16_t* wpt, const float* pscale) {
    const int tid = threadIdx.x, lane = tid & 63, wid = __builtin_amdgcn_readfirstlane(tid >> 6), r32 = lane & 31, hi = lane >> 5;
    const bf16_t* Zb = Z + (size_t)b * LP * DIN;
    const int pp0 = 64 * jb;
    const int g = wid >> 1, rh = wid & 1;
    bf16x8 afr[4][2]; f32x4 scv[2][4];
#pragma unroll
    for (int ks = 0; ks < 4; ++ks)
#pragma unroll
        for (int dh = 0; dh < 2; ++dh) afr[ks][dh] = *(const bf16x8*)(wpt + ((size_t)g * 64 + 32 * dh + r32) * 64 + 16 * ks + 8 * hi);
#pragma unroll
    for (int dh = 0; dh < 2; ++dh)
#pragma unroll
        for (int rq = 0; rq < 4; ++rq) scv[dh][rq] = *(const f32x4*)(pscale + 64 * g + 32 * dh + 8 * rq + 4 * hi);
#pragma unroll
    for (int it = 0; it < 5; ++it) { const int idx = tid + 512 * it, row = idx >> 5, ch = idx & 31;
        *(LAS u32x4*)(lds + CL_U + row * 528 + ch * 16) = *(const u32x4*)(Zb + (size_t)(pp0 - 16 + row) * DIN + ZUC + 8 * ch); }
    __syncthreads();
    { const int t = tid >> 3, pos = pp0 + t - PADP;
#pragma unroll
      for (int cc = 0; cc < 4; ++cc) { const int ch = (tid & 7) * 4 + cc, g = ch >> 3, w = 2 << g; int cnt = pos + 1 < w ? pos + 1 : w; cnt = cnt < 1 ? 1 : cnt;
          float acc[8];
#pragma unroll
          for (int e = 0; e < 8; ++e) acc[e] = 0.f;
          u32x4 x0 = (u32x4){0u, 0u, 0u, 0u};
          for (int j = 0; j < cnt; ++j) { const u32x4 x = *(const LAS u32x4*)(lds + CL_U + (16 + t - j) * 528 + ch * 16); if (j == 0) x0 = x;
              acc[0] += bf16_lo(x.x); acc[1] += bf16_hi(x.x); acc[2] += bf16_lo(x.y); acc[3] += bf16_hi(x.y); acc[4] += bf16_lo(x.z); acc[5] += bf16_hi(x.z); acc[6] += bf16_lo(x.w); acc[7] += bf16_hi(x.w); }
          const float ic = 1.0f / (float)cnt;
          u32x4 d; d.x = cvt_pk_bf16(acc[0] * ic - bf16_lo(x0.x), acc[1] * ic - bf16_hi(x0.x)); d.y = cvt_pk_bf16(acc[2] * ic - bf16_lo(x0.y), acc[3] * ic - bf16_hi(x0.y));
          d.z = cvt_pk_bf16(acc[4] * ic - bf16_lo(x0.z), acc[5] * ic - bf16_hi(x0.z)); d.w = cvt_pk_bf16(acc[6] * ic - bf16_lo(x0.w), acc[7] * ic - bf16_hi(x0.w));
          *(LAS u32x4*)(lds + CL_D + t * 528 + ch * 16) = d; } }
    __syncthreads();
    f32x16 acc[2]; acc[0] = (f32x16){}; acc[1] = (f32x16){};
#pragma unroll
    for (int ks = 0; ks < 4; ++ks) { const bf16x8 bfrag = *(const LAS bf16x8*)(lds + CL_D + (32 * rh + r32) * 528 + (64 * g + 16 * ks + 8 * hi) * 2);
#pragma unroll
        for (int dh = 0; dh < 2; ++dh) acc[dh] = __builtin_amdgcn_mfma_f32_32x32x16_bf16(afr[ks][dh], bfrag, acc[dh], 0, 0, 0); }
    bf16_t* orow = mix_row(mix, mixm, b, pp0 + 32 * rh + r32);
    if (orow) {
#pragma unroll
        for (int dh = 0; dh < 2; ++dh)
#pragma unroll
            for (int rq = 0; rq < 4; ++rq) { const int dd = 32 * dh + 8 * rq + 4 * hi; const f32x4 sc = scv[dh][rq];
                u32x2 w; w.x = cvt_pk_bf16(acc[dh][4 * rq] * sc[0], acc[dh][4 * rq + 1] * sc[1]); w.y = cvt_pk_bf16(acc[dh][4 * rq + 2] * sc[2], acc[dh][4 * rq + 3] * sc[3]);
                *(u32x2*)(orow + 768 + 64 * g + dd) = w; }
    }
    __syncthreads();
}
__device__ __forceinline__ void cvt_item(const float* s0, const float* s1, int ld, bf16_t* dst, int K, const float* gk, LAS unsigned* scr, int lane) {
    const int c = lane & 15, q = lane >> 4;
    const float* src = ((c >> 3) ? s1 : s0) + 4 * (c & 7);
    f32x4 a[8], b[8];
#pragma unroll
    for (int jj = 0; jj < 8; ++jj) { const int k = 8 * jj + 2 * q; a[jj] = __builtin_nontemporal_load((const f32x4*)(src + (size_t)k * ld)); b[jj] = __builtin_nontemporal_load((const f32x4*)(src + (size_t)(k + 1) * ld)); }
#pragma unroll
    for (int jj = 0; jj < 8; ++jj) { const int k = 8 * jj + 2 * q; float g0 = 1.f, g1 = 1.f; if (gk) { g0 = gk[k]; g1 = gk[k + 1]; }
#pragma unroll
        for (int e = 0; e < 4; ++e) scr[(4 * c + e) * 33 + 4 * jj + q] = cvt_pk_bf16(a[jj][e] * g0, b[jj][e] * g1); }
    LDS_WAIT(); asm volatile("" ::: "memory");
#pragma unroll
    for (int p = 0; p < 8; ++p) { const int n = p * 8 + (lane >> 3), ch = lane & 7; const LAS unsigned* s = scr + n * 33 + 4 * ch;
        u32x4 o; o.x = s[0]; o.y = s[1]; o.z = s[2]; o.w = s[3];
        __builtin_nontemporal_store(o, (u32x4*)(dst + (size_t)n * K + 8 * ch)); }
    LDS_WAIT(); asm volatile("" ::: "memory");
}

__device__ __forceinline__ void cvt_item8(const float* s0, const float* s1, int ld, unsigned char* dst, int KB, const float* gk, float sc, LAS unsigned* scr, int lane) {
    const int c = lane & 15, q = lane >> 4;
    const float* src = ((c >> 3) ? s1 : s0) + 4 * (c & 7);
    f32x4 v[4][4];
#pragma unroll
    for (int jj = 0; jj < 4; ++jj)
#pragma unroll
        for (int i = 0; i < 4; ++i) v[jj][i] = __builtin_nontemporal_load((const f32x4*)(src + (size_t)(16 * jj + 4 * q + i) * ld));
#pragma unroll
    for (int jj = 0; jj < 4; ++jj) { float g[4];
#pragma unroll
        for (int i = 0; i < 4; ++i) g[i] = (gk ? gk[16 * jj + 4 * q + i] : 1.0f) * sc;
#pragma unroll
        for (int e = 0; e < 4; ++e) scr[(4 * c + e) * 17 + 4 * jj + q] = pack4_fp8(v[jj][0][e] * g[0], v[jj][1][e] * g[1], v[jj][2][e] * g[2], v[jj][3][e] * g[3]); }
    LDS_WAIT(); asm volatile("" ::: "memory");
#pragma unroll
    for (int p = 0; p < 4; ++p) { const int n = p * 16 + (lane >> 2), ch = lane & 3; const LAS unsigned* s = scr + n * 17 + 4 * ch;
        u32x4 o; o.x = s[0]; o.y = s[1]; o.z = s[2]; o.w = s[3];
        __builtin_nontemporal_store(o, (u32x4*)(dst + (size_t)n * KB + 16 * ch)); }
    LDS_WAIT(); asm volatile("" ::: "memory");
}

struct ProArgs {
    const float *x, *meta, *relb, *g_mix, *w_in, *gain_a, *gain_b, *dlam, *w_pool, *w_out, *g_ffn, *wg, *wu, *wd, *w_router, *weg, *weu, *wed;
    unsigned char* ws;
};
constexpr int IT_WIN = 2 * 16 * 28, IT_WOUT = 2 * 16 * 16, IT_WGU = 16 * 88, IT_WD = 44 * 16, IT_WEGU = 8 * 16 * 112, IT_WED = 8 * 56 * 16;
constexpr int IT_TOTAL = IT_WIN + IT_WOUT + IT_WGU + IT_WD + IT_WEGU + IT_WED;
constexpr size_t MS_GT = MS_END;
constexpr size_t MS_LAM = MS_GT + 2 * 4 * 64 * 4;
constexpr size_t MS_BT = MS_LAM + 256;
constexpr size_t MS_BCHK = MS_BT + 4 * 7 * 4096;
constexpr size_t MS_WRB = MS_BCHK + 256;
static_assert(MS_WRB + 16 * 1024 * 2 <= 10 * MiB, "misc map");

__device__ __forceinline__ void convert_item(const ProArgs& P, int it, LAS unsigned* scr, int lane) {
    unsigned char* ws = P.ws;
    if (it < IT_WIN) { const int l = it / (16 * 28), r = it % (16 * 28), kb = r / 28, nb = r % 28, T = nb >> 2, blk = nb & 3, c = blk >> 1, hp = blk & 1;
        const float* W = P.w_in + (size_t)l * D * DIN + (size_t)(64 * kb) * DIN + 256 * T + 32 * c;
        cvt_item(W + 64 * (2 * hp), W + 64 * (2 * hp + 1), DIN, (bf16_t*)(ws + WS_WIN) + ((size_t)l * DIN + 64 * nb) * D + 64 * kb, D, P.g_mix + l * D + 64 * kb, scr, lane); return; }
    it -= IT_WIN;
    if (it < IT_WOUT) { const int l = it / 256, r = it % 256, kb = r / 16, nb = r % 16;
        const float* W = P.w_out + (size_t)l * D * D + (size_t)(64 * kb) * D + 64 * nb;
        cvt_item(W, W + 32, D, (bf16_t*)(ws + WS_WOUT) + ((size_t)l * D + 64 * nb) * D + 64 * kb, D, nullptr, scr, lane); return; }
    it -= IT_WOUT;
    if (it < IT_WGU) { const int kb = it / 88, nb = it % 88, T = nb >> 2, blk = nb & 3;
        const float* W = ((blk < 2) ? P.wg : P.wu) + (size_t)(64 * kb) * DFF + 128 * T + 64 * (blk & 1);
        cvt_item(W, W + 32, DFF, (bf16_t*)(ws + WS_WGU) + ((size_t)64 * nb) * D + 64 * kb, D, P.g_ffn + 64 * kb, scr, lane); return; }
    it -= IT_WGU;
    if (it < IT_WD) { const int kb = it / 16, nb = it % 16;
        const float* W = P.wd + (size_t)(64 * kb) * D + 64 * nb;
        cvt_item(W, W + 32, D, (bf16_t*)(ws + WS_WD) + ((size_t)64 * nb) * DFF + 64 * kb, DFF, nullptr, scr, lane); return; }
    it -= IT_WD;
    if (it < IT_WEGU) { const int e = it / (16 * 112), r = it % (16 * 112), kb = r / 112, nb = r % 112, T = nb >> 2, blk = nb & 3;
        const float* W = ((blk < 2) ? P.weg : P.weu) + (size_t)e * D * DFE + (size_t)(64 * kb) * DFE + 128 * T + 64 * (blk & 1);
        cvt_item8(W, W + 32, DFE, ws + WS_WEGU + ((size_t)e * 2 * DFE + 64 * nb) * D + 64 * kb, D, P.g_ffn + D + 64 * kb, (float)(1 << WEGU_SH), scr, lane); return; }
    it -= IT_WEGU;
    { const int e = it / (56 * 16), r = it % (56 * 16), kb = r / 16, nb = r % 16;
        const float* W = P.wed + (size_t)e * DFE * D + (size_t)(64 * kb) * D + 64 * nb;
        cvt_item8(W, W + 32, D, ws + WS_WED + ((size_t)e * D + 64 * nb) * DFE + 64 * kb, DFE, nullptr, (float)(1 << WED_SH), scr, lane); }
}

__device__ __forceinline__ void row_setup(const float* xrow, bf16_t* hb, float* ssp, float* fcopy, int lane, int nssp4) {
    const f32x4* xr = (const f32x4*)xrow + lane; f32x4 v[4]; float s = 0.f;
#pragma unroll
    for (int j = 0; j < 4; ++j) { v[j] = __builtin_nontemporal_load(xr + 64 * j); s += (v[j][0] * v[j][0] + v[j][1] * v[j][1]) + (v[j][2] * v[j][2] + v[j][3] * v[j][3]); }
    s = wave_sum(s);
#pragma unroll
    for (int j = 0; j < 4; ++j) { u32x2 w; w.x = cvt_pk_bf16(v[j][0], v[j][1]); w.y = cvt_pk_bf16(v[j][2], v[j][3]); *((u32x2*)hb + lane + 64 * j) = w; if (fcopy) *((f32x4*)fcopy + lane + 64 * j) = v[j]; }
    if (lane < nssp4) *((f32x4*)ssp + lane) = (f32x4){lane == 0 ? s : 0.f, 0.f, 0.f, 0.f};
}

__device__ __forceinline__ int t5_bucket(int n) {
    if (n < 16) return n;
    const int v = 16 + (int)(__logf((float)n * (1.0f / 16.0f)) / 2.0794415416798357f * 16.0f);
    return v < 31 ? v : 31;
}

__device__ __forceinline__ void prologue(const ProArgs& P, LAS unsigned char* lds, int vcu, int G) {
    const int tid = threadIdx.x, lane = tid & 63, wave = __builtin_amdgcn_readfirstlane(tid >> 6);
    unsigned char* ws = P.ws; unsigned char* ms = ws + WS_MISC;
    const int gw = vcu * NWAVES + wave, NGW = G * NWAVES, gt_ = vcu * NTHREADS + tid, NGT = G * NTHREADS;
    for (int m = gw; m < M; m += NGW) row_setup(P.x + (size_t)m * D, (bf16_t*)(ws + WS_HB) + (size_t)m * D, (float*)(ms + MS_SSP) + (size_t)m * 4, nullptr, lane, 1);
    if (gw < NMETA) row_setup(P.meta + (size_t)gw * D, (bf16_t*)(ms + MS_HMB) + (size_t)gw * D, (float*)(ms + MS_SSPM) + gw * 16, (float*)(ms + MS_HM) + (size_t)gw * D, lane, 4);
    for (int i = gt_; i < 12 * 128; i += NGT) { const int h = i >> 7, n = i & 127; const float v = P.relb[t5_bucket(n) * 12 + h] * LOG2E;
        if (h < 8) ((float*)(ms + MS_LUTA))[h * 128 + n] = v; else ((float*)(ms + MS_LUTB))[(h - 8) * 128 + n] = v; }
    for (int i = gt_; i < 2 * 4 * 64; i += NGT) { const int l = i >> 8, t = (i >> 6) & 3, j = i & 63; float v = 0.f;
        if (t == 0) v = P.gain_a[(l * 2 + 0) * 64 + j] * 0.125f * LOG2E; else if (t == 1) v = P.gain_a[(l * 2 + 1) * 64 + j];
        else if (t == 2) { if (j < 32) v = P.gain_b[(l * 2 + 0) * 32 + j] * 0.17677669529663687f * LOG2E; } else { if (j < 32) v = P.gain_b[(l * 2 + 1) * 32 + j]; }
        ((float*)(ms + MS_GT))[i] = v; }
    if (gt_ < 2) { const int l = gt_; const float* dl = P.dlam + l * 128; float s1 = 0.f, s2 = 0.f;
        for (int j = 0; j < 32; ++j) { s1 += dl[j] * dl[32 + j]; s2 += dl[64 + j] * dl[96 + j]; }
        ((float*)(ms + MS_LAM))[l] = __expf(s1) - __expf(s2) + (0.8f - 0.6f * __expf(-0.3f * (float)l)); }
    for (int i = gt_; i < 2 * 4 * 64 * 64; i += NGT) { const int c = i & 63, dd = (i >> 6) & 63, lg = i >> 12;
        const float v = P.w_pool[((size_t)lg * 64 + c) * 64 + dd]; ((bf16_t*)(ms + MS_WPT))[i] = (bf16_t)(cvt_pk_bf16(v, 0.f) & 0xffffu); }
    for (int i = gt_; i < 1024 * 8; i += NGT) { const float wv = P.w_router[i] * P.g_ffn[D + (i >> 3)]; ((float*)(ms + MS_WR))[i] = wv;
        const int k = i >> 3, e = i & 7; const unsigned hi = cvt_pk_bf16(wv, 0.f) & 0xffffu; const unsigned lo = cvt_pk_bf16(wv - __uint_as_float(hi << 16), 0.f) & 0xffffu;
        ((bf16_t*)(ms + MS_WRB))[e * 1024 + k] = (bf16_t)hi; ((bf16_t*)(ms + MS_WRB))[(8 + e) * 1024 + k] = (bf16_t)lo; }
    if (gw < 8) { const int l = gw >> 2, h = gw & 3, j = lane & 31;
        float gq = fabsf(P.gain_b[(l * 2 + 0) * 32 + j]) * 0.17677669529663687f * LOG2E, gk = fabsf(P.gain_b[(l * 2 + 1) * 32 + j]);
        const float b0 = P.relb[t5_bucket(lane) * 12 + 8 + h] * LOG2E, b1 = P.relb[t5_bucket(lane + 64) * 12 + 8 + h] * LOG2E; float bmax = fmaxf(b0, b1), bmin = fminf(b0, b1);
#pragma unroll
        for (int o = 1; o < 64; o <<= 1) { gq = fmaxf(gq, __shfl_xor(gq, o)); gk = fmaxf(gk, __shfl_xor(gk, o)); bmax = fmaxf(bmax, __shfl_xor(bmax, o)); bmin = fminf(bmin, __shfl_xor(bmin, o)); }
        const float bound = 64.0f * 1.02f * gq * gk + (bmax - bmin);
        if (lane == 0) ((int*)(ms + MS_BCHK))[gw] = (bound < 96.0f) ? 0 : 1; }
    for (int i = gt_; i < 4 * 7 * 1024; i += NGT) { const int h = i / 7168, rem = i - h * 7168, j = rem >> 10, e = rem & 1023, ln = e >> 4, r = e & 15; const int n = 32 * (j - 1) + (ln & 31) - ((r & 3) + 8 * (r >> 2) + 4 * (ln >> 5));
        ((float*)(ms + MS_BT))[h * 7168 + j * 1024 + (r >> 2) * 256 + ln * 4 + (r & 3)] = n < 0 ? NEGF : P.relb[t5_bucket(n > 127 ? 127 : n) * 12 + 8 + h] * LOG2E; }
    { const int per = PADP * DIN * 2 / 16; for (int i = gt_; i < NBATCH * per; i += NGT) { const int b = i / per, r = i % per; *((u32x4*)(ws + WS_Z + (size_t)b * LP * DIN * 2) + r) = (u32x4){0u, 0u, 0u, 0u}; } }
    LAS unsigned* scr = (LAS unsigned*)lds + wave * (64 * 33);
    for (int it = gw; it < IT_TOTAL; it += NGW) convert_item(P, it, scr, lane);
}

__device__ __forceinline__ void router_phase(LAS unsigned char* lds, const bf16_t* hres, const bf16_t* wrb, const float* ssp4, float* lrs, int* ltok, float* lgate, unsigned* cnt, int vcu, int G) {
    const int tid = threadIdx.x, lane = tid & 63, wave = __builtin_amdgcn_readfirstlane(tid >> 6);
    LAS int* e0s = (LAS int*)lds; LAS int* e1s = e0s + 128; LAS float* g0s = (LAS float*)(e1s + 128); LAS float* g1s = g0s + 128;
    LAS unsigned* lcnt = (LAS unsigned*)(g1s + 128); LAS unsigned* lbase = lcnt + 16; LAS unsigned* rk0 = lbase + 16; LAS unsigned* rk1 = rk0 + 128; LAS float* rss = (LAS float*)(rk1 + 128);
    for (int chunk = vcu; chunk < M / 128; chunk += G) {
        if (tid < 16) lcnt[tid] = 0u;
        {
            const int tok0 = chunk * 128 + wave * 16;
            const bf16_t* hb = hres + (size_t)(tok0 + (lane & 15)) * D + 8 * (lane >> 4);
            const bf16_t* wb = wrb + (size_t)(lane & 15) * D + 8 * (lane >> 4);
            f32x4 acc = (f32x4){0.f, 0.f, 0.f, 0.f};
#pragma unroll 8
            for (int k0 = 0; k0 < D; k0 += 32) acc = __builtin_amdgcn_mfma_f32_16x16x32_bf16(*(const bf16x8*)(wb + k0), *(const bf16x8*)(hb + k0), acc, 0, 0, 0);
            float lg[8];
#pragma unroll
            for (int i = 0; i < 4; ++i) { const float s = xor32_add(acc[i]);
                const auto r = __builtin_amdgcn_permlane16_swap(__float_as_uint(s), __float_as_uint(s), false, false); lg[i] = __uint_as_float(r[0]); lg[4 + i] = __uint_as_float(r[1]); }
            if (lane < 16) {
                const f32x4 q4 = *(const f32x4*)(ssp4 + (size_t)(tok0 + lane) * 4);
                const float rs = __builtin_amdgcn_rsqf(((q4[0] + q4[1]) + (q4[2] + q4[3])) * (1.0f / D) + EPS);
                int b0 = 0; float v0 = lg[0] * rs;
#pragma unroll
                for (int e = 1; e < 8; ++e) { const float v = lg[e] * rs; if (v > v0) { v0 = v; b0 = e; } }
                int b1 = -1; float v1 = 0.f;
#pragma unroll
                for (int e = 0; e < 8; ++e) { const float v = lg[e] * rs; if (e != b0 && (b1 < 0 || v > v1)) { v1 = v; b1 = e; } }
                const float ex = __expf(v1 - v0), gg0 = 1.0f / (1.0f + ex), gg1 = ex * gg0;
                const int s = wave * 16 + lane; e0s[s] = b0; e1s[s] = b1; g0s[s] = gg0; g1s[s] = gg1; rss[s] = rs;
            }
        }
        __syncthreads();
        if (tid < 128) { rk0[tid] = __hip_atomic_fetch_add(&lcnt[e0s[tid]], 1u, __ATOMIC_RELAXED, __HIP_MEMORY_SCOPE_WORKGROUP); rk1[tid] = __hip_atomic_fetch_add(&lcnt[8 + e1s[tid]], 1u, __ATOMIC_RELAXED, __HIP_MEMORY_SCOPE_WORKGROUP); }
        __syncthreads();
        if (tid < 16) lbase[tid] = __hip_atomic_fetch_add(cnt + 64 * tid, lcnt[tid], __ATOMIC_RELAXED, __HIP_MEMORY_SCOPE_AGENT);
        __syncthreads();
        if (tid < 128) { const int tok = chunk * 128 + tid; const int ga = e0s[tid], gb = 8 + e1s[tid];
            const unsigned sa = lbase[ga] + rk0[tid], sb = lbase[gb] + rk1[tid];
            ltok[(size_t)ga * LCAP + sa] = tok; lgate[(size_t)ga * LCAP + sa] = g0s[tid]; lrs[(size_t)ga * LCAP + sa] = rss[tid]; ltok[(size_t)gb * LCAP + sb] = tok; lgate[(size_t)gb * LCAP + sb] = g1s[tid]; lrs[(size_t)gb * LCAP + sb] = rss[tid]; }
        __syncthreads();
    }
}

constexpr int MOE_TMAX = 144;
__device__ __forceinline__ void moe_tables_fill(const unsigned* cnt, volatile LAS unsigned* tab, volatile LAS unsigned* tmap) {
    const int lane = threadIdx.x & 63; int cl = 0;
    if (lane < 16) cl = (int)__hip_atomic_load(cnt + 64 * lane, __ATOMIC_RELAXED, __HIP_MEMORY_SCOPE_AGENT);
#pragma unroll
    for (int k = 0; k < 2; ++k) { int s = 0; int me = 0, mlt = 0; const int j = threadIdx.x;
#pragma unroll
        for (int e = 0; e < 8; ++e) { const int c = __builtin_amdgcn_readlane(cl, k * 8 + e);
            if (threadIdx.x == 0) { tab[32 * k + e] = (unsigned)s; tab[32 * k + 16 + e] = (unsigned)c; }
            const int nt = (c + 255) >> 8; if (j >= s && j < s + nt) { me = e; mlt = j - s; } s += nt; }
        if (threadIdx.x == 0) tab[32 * k + 8] = (unsigned)s;
        if (j < MOE_TMAX) tmap[MOE_TMAX * k + j] = (unsigned)((me << 16) | mlt); }
    __syncthreads();
}
__device__ __forceinline__ MoeTab moe_tab(volatile LAS unsigned* tab, volatile LAS unsigned* tmap, int k) { MoeTab T; T.ts = (const LAS int*)tab + 32 * k; T.cnt = (const LAS int*)tab + 32 * k + 16; T.tile = (const LAS int*)tmap + MOE_TMAX * k;
    T.nM = __builtin_amdgcn_readfirstlane(T.ts[8]); return T; }
#define XB_TMO      128
#define XB_XCNT(j)  (256  + 64 * (j))
#define XB_XSUB(j)  (1280 + 64 * (j))
#define XB_XGEN(j)  (2304 + 64 * (j))
#define XB_TOP      3328
#define XB_TOPGEN   3392
#define XCD_BAR_WORDS 3456
#define XB_SPIN_CAP (1u << 18)
__device__ __forceinline__ unsigned xb_ld(unsigned* p)              { return __hip_atomic_load(p, __ATOMIC_RELAXED, __HIP_MEMORY_SCOPE_AGENT); }
__device__ __forceinline__ unsigned xb_add(unsigned* p, unsigned v) { return __hip_atomic_fetch_add(p, v, __ATOMIC_RELAXED, __HIP_MEMORY_SCOPE_AGENT); }
__device__ __forceinline__ unsigned xb_xcc_id() { return (unsigned)__builtin_amdgcn_s_getreg((3 << 11) | 20) & 0xFu; }
#define XB_SPIN(cond, bar) do { unsigned _sp = 0; while (cond) { __builtin_amdgcn_s_sleep(1); \
    if ((++_sp & 255u) == 0u) { if (xb_ld(&(bar)[XB_TMO])) break; if (_sp > XB_SPIN_CAP) { atomicAdd(&(bar)[XB_TMO], 1u); break; } } } } while (0)
struct XcdBarrier { unsigned* bar; unsigned x; volatile LAS unsigned* st; };
__device__ __forceinline__ XcdBarrier xcd_barrier_post(unsigned* bar, volatile LAS unsigned* st) {
    XcdBarrier b; b.bar = bar; b.x = xb_xcc_id(); b.st = st;
    if (threadIdx.x == 0) (void)xb_add(&bar[XB_XCNT(b.x)], 1u);
    return b;
}
__device__ __forceinline__ void xcd_barrier_complete(unsigned* bar, unsigned x, unsigned& nloc, unsigned& nx) {
    const unsigned G = gridDim.x * gridDim.y * gridDim.z;
    unsigned sum, cnt, mine, sp = 0u;
    for (;;) {
        sum = 0u; cnt = 0u; mine = 0u;
#pragma unroll
        for (unsigned j = 0; j < 16; ++j) { const unsigned c = xb_ld(&bar[XB_XCNT(j)]); sum += c; cnt += (c > 0u) ? 1u : 0u; mine = (j == x) ? c : mine; }
        if (sum == G) break;
        __builtin_amdgcn_s_sleep(1);
        if ((++sp & 255u) == 0u) { if (xb_ld(&bar[XB_TMO])) break; if (sp > XB_SPIN_CAP) { atomicAdd(&bar[XB_TMO], 1u); break; } }
    }
    nloc = mine > 0u ? mine : 1u; nx = cnt > 0u ? cnt : 1u;
}
__device__ __forceinline__ void xcd_barrier(const XcdBarrier& b) {
    asm volatile("s_waitcnt vmcnt(0)" ::: "memory");
    __syncthreads();
    if (threadIdx.x == 0) {
        unsigned* bar = b.bar;
        __builtin_amdgcn_s_waitcnt(0);
        unsigned nloc = b.st[0], nx = b.st[1];
        if (nloc == 0u) { xcd_barrier_complete(bar, b.x, nloc, nx); b.st[0] = nloc; b.st[1] = nx; }
        const unsigned old = xb_add(&bar[XB_XSUB(b.x)], 1u);
        const unsigned gen = old / nloc;
        if (old + 1u == (gen + 1u) * nloc) {
            __builtin_amdgcn_fence(__ATOMIC_RELEASE, "agent");
            asm volatile("s_waitcnt vmcnt(0)" ::: "memory");
            const unsigned og = xb_add(&bar[XB_TOP], 1u);
            const unsigned tg = og / nx;
            if (og + 1u == (tg + 1u) * nx) xb_add(&bar[XB_TOPGEN], 1u);
            else XB_SPIN(xb_ld(&bar[XB_TOPGEN]) == tg, bar);
            __builtin_amdgcn_fence(__ATOMIC_ACQUIRE, "agent");
            xb_add(&bar[XB_XGEN(b.x)], 1u);
            asm volatile("s_waitcnt vmcnt(0)" ::: "memory");
        } else {
            XB_SPIN(xb_ld(&bar[XB_XGEN(b.x)]) == gen, bar);
            __builtin_amdgcn_fence(__ATOMIC_ACQUIRE, "agent");
            asm volatile("s_waitcnt vmcnt(0)" ::: "memory");
        }
    }
    __syncthreads();
}

constexpr int RING_BYTES = 131072, LDS_TOK = RING_BYTES, LDSCTL_OFF = RING_BYTES + 1024 + 3 * pg8::AUX_BUF, LDS_BYTES = 147456;
static_assert(LDSCTL_OFF + 1024 + 2 * MOE_TMAX * 4 <= LDS_BYTES, "LDS map");
static_assert(AL_END <= RING_BYTES && BL_END <= RING_BYTES && CL_END <= RING_BYTES && pg8::TOK_LDS_OFF == LDS_TOK, "LDS map");

#ifndef MK_PER_PHASE
#define MK_PER_PHASE 0
#endif
#ifndef PH_LIMIT
#define PH_LIMIT 15
#endif
constexpr int N_PHASES = PH_LIMIT;

struct Args { const float* in[21]; float* out; unsigned char* ws; int ph_lo, ph_hi; };

template <int L> __device__ __forceinline__ void mixer_phase(const Args& a, LAS unsigned char* lds, volatile LAS unsigned* MISC, gu32* ctl, int qrep) {
    unsigned char* ws = a.ws; unsigned char* ms = ws + WS_MISC;
    const bf16_t* Z = (const bf16_t*)(ws + WS_Z); bf16_t* mix = (bf16_t*)(ws + WS_MIX); bf16_t* mixm = (bf16_t*)(ms + MS_MIXM);
    const float* lutA = (const float*)(ms + MS_LUTA); const float* lutB = (const float*)(ms + MS_LUTB); const float* btiles = (const float*)(ms + MS_BT); const int* bchkp = (const int*)(ms + MS_BCHK) + L * 4; const int bchk4 = __builtin_amdgcn_readfirstlane((bchkp[0] != 0 ? 1 : 0) | (bchkp[1] != 0 ? 2 : 0) | (bchkp[2] != 0 ? 4 : 0) | (bchkp[3] != 0 ? 8 : 0));
    const float lam = ((const float*)(ms + MS_LAM))[L]; const float omli = 1.0f - (0.8f - 0.6f * __expf(-0.3f * (float)L));
    const float* sinks = a.in[6] + L * 8; const float* gout = a.in[9] + L * 64; const float* pscale = a.in[11] + L * 256;
    const bf16_t* wpt = (const bf16_t*)(ms + MS_WPT) + (size_t)L * 4 * 64 * 64;
    constexpr int NBU = 1024, NBM = (L == 0) ? 4 : 0, NAU = 512, NAM = (L == 0) ? 2 : 0, NCU = 512, NCM = (L == 0) ? 1 : 0;
#define QPOP(q) __hip_atomic_fetch_add(ctl + CW_QUEUE + 64 * (6 * L + (q) + 12 * qrep), 1u, __ATOMIC_RELAXED, __HIP_MEMORY_SCOPE_AGENT)
#define QPOP_ASYNC(q) __hip_atomic_fetch_add(ctl + CW_QUEUE + 64 * (6 * L + (q) + 12 * qrep) + qzero, 1u, __ATOMIC_RELAXED, __HIP_MEMORY_SCOPE_AGENT)
#define QUEUE_LOOP(q, END, BODY) { unsigned pf = 0u; unsigned qzero = 0u; asm volatile("" : "+v"(qzero)); if (threadIdx.x == 0) MISC[4] = QPOP(q); __syncthreads(); int u = (int)MISC[4]; __syncthreads(); \
        while (u < (END)) { if (threadIdx.x == 0) pf = QPOP_ASYNC(q); BODY \
            if (threadIdx.x == 0) MISC[4] = pf; __syncthreads(); u = (int)MISC[4]; __syncthreads(); } }
#ifndef MIXREP
#define MIXREP 0
#endif
    const int xq = blockIdx.x & 7; bool bt_load = true; float bcfar = 0.f;
#define LOOP_B(qq) QUEUE_LOOP(24 + 2 * L + xq, NBU / 8 + ((NBM != 0 && xq < NBM) ? 1 : 0), \
        if (u < NBU / 8) { const int ib = 16 - (u >> 3); const int r = xq + 8 * (u & 7); attnB_unit(lds, r >> 2, r & 3, ib, Z, mix, mixm, lutB, btiles, bt_load, bcfar, ((bchk4 >> (r & 3)) & 1) != 0, lam, omli, gout); } \
        else attnB_unit(lds, 0, xq, 0, Z, mix, mixm, lutB, btiles, bt_load, bcfar, ((bchk4 >> xq) & 1) != 0, lam, omli, gout); \
        bt_load = false; )
#define LOOP_A(qq) QUEUE_LOOP(40 + 2 * L + xq, NAU / 8 + ((NAM != 0 && xq < NAM) ? 1 : 0), \
        if (u < NAU / 8) { const int ib = 1 + (u & 15); const int r = xq + 8 * (u >> 4); attnA_unit(lds, r >> 1, r & 1, ib, Z, mix, mixm, lutA, sinks); } \
        else attnA_unit(lds, 0, xq, 0, Z, mix, mixm, lutA, sinks); )
#define LOOP_C(qq) QUEUE_LOOP(qq, NCU + NCM, \
        if (u < NCU) pool_unit(lds, u >> 5, 2 + (u & 31), Z, mix, mixm, wpt, pscale); \
        else pool_unit(lds, 0, 1, Z, mix, mixm, wpt, pscale); )
    LOOP_B(0)
    if (MIXREP & 1) { LOOP_B(3) }
    LOOP_A(1)
    if (MIXREP & 2) { LOOP_A(4) }
    LOOP_C(2)
    if (MIXREP & 4) { LOOP_C(5) }
#undef LOOP_A
#undef LOOP_B
#undef LOOP_C
#undef QUEUE_LOOP
#undef QPOP
#undef QPOP_ASYNC
}

__global__ void __launch_bounds__(NTHREADS, 2) fwd_kernel(Args a) {
    extern __shared__ __attribute__((aligned(16))) unsigned char lds_raw[];
    LAS unsigned char* lds = (LAS unsigned char*)lds_raw;
    volatile LAS unsigned* MISC = (volatile LAS unsigned*)(lds + LDSCTL_OFF);
    const int tid = threadIdx.x;
    const int G = gridDim.x, bx = blockIdx.x, vcu = (G % 8 == 0) ? (bx % 8) * (G / 8) + bx / 8 : bx;
    unsigned char* ws = a.ws; unsigned char* ms = ws + WS_MISC;
    gu32* ctl = (gu32*)(ws + WS_CTL);
    for (int u = tid; u < 64; u += NTHREADS) MISC[u] = 0u;
    __syncthreads();
    XcdBarrier bar; bar.bar = (unsigned*)(ctl + CW_BAR); bar.x = 0; bar.st = nullptr;
    if (!MK_PER_PHASE) bar = xcd_barrier_post((unsigned*)(ctl + CW_BAR), MISC + 8);
    const int lo = a.ph_lo, hi = a.ph_hi;
#ifndef PH_MASK
#define PH_MASK 0xffffffffu
#endif
#define IN(k) (((PH_MASK >> (k)) & 1u) && lo <= (k) && (k) < hi)
#define SEAM(k) do { if (IN(k) && IN((k) + 1)) xcd_barrier(bar); } while (0)
#ifndef REP_MASK
#define REP_MASK 0u
#endif
#define REPS(k) (((REP_MASK >> (k)) & 1u) ? 2 : 1)
    bf16_t* HB = (bf16_t*)(ws + WS_HB); float* SSP = (float*)(ms + MS_SSP);
    bf16_t* Zb = (bf16_t*)(ws + WS_Z); bf16_t* MIX = (bf16_t*)(ws + WS_MIX);
    float* HM = (float*)(ms + MS_HM); bf16_t* HMB = (bf16_t*)(ms + MS_HMB); float* SSPM = (float*)(ms + MS_SSPM); bf16_t* MIXM = (bf16_t*)(ms + MS_MIXM); bf16_t* ACTM = (bf16_t*)(ms + MS_ACTM);
    const float* GT = (const float*)(ms + MS_GT);
    LAS float* ROWSUM = (LAS float*)(lds + pg8::AUX_LDS_OFF);
    const int mj0 = G - 1 - bx;

    if (IN(0)) _Pragma("unroll") for (int rep = 0; rep < REPS(0); ++rep) { if (rep) xcd_barrier(bar);
        ProArgs P; P.x = a.in[0]; P.meta = a.in[1]; P.relb = a.in[2]; P.g_mix = a.in[3]; P.w_in = a.in[4]; P.gain_a = a.in[5]; P.gain_b = a.in[7]; P.dlam = a.in[8]; P.w_pool = a.in[10];
        P.w_out = a.in[12]; P.g_ffn = a.in[13]; P.wg = a.in[14]; P.wu = a.in[15]; P.wd = a.in[16]; P.w_router = a.in[17]; P.weg = a.in[18]; P.weu = a.in[19]; P.wed = a.in[20]; P.ws = ws;
        prologue(P, lds, vcu, G);
    }
    SEAM(0);
    if (IN(1)) _Pragma("unroll") for (int rep = 0; rep < REPS(1); ++rep) { if (rep) xcd_barrier(bar);
        for (int j = mj0; j < 28; j += G) meta_inproj_unit(lds, j, HMB, (const bf16_t*)(ws + WS_WIN), SSPM, GT, Zb);
        SchedDenseT<4, DIN / 256> S{M / 256, G, bx, (const char*)HB, (const char*)(ws + WS_WIN), (size_t)256 * D * 2, SSP};
        LAS float* GL = (LAS float*)(lds + LDSCTL_OFF + 1024); if (tid < 256) GL[tid] = GT[tid]; __syncthreads();
        EpiInProj E{Zb, SSP, GL};
        pg8::gemm_phase(lds, 2 * D, S, E);
    }
    SEAM(1);
    if (IN(2)) { mixer_phase<0>(a, lds, MISC, ctl, 0); if (REPS(2) > 1) { xcd_barrier(bar); mixer_phase<0>(a, lds, MISC, ctl, 1); } }
    SEAM(2);
    if (IN(3)) _Pragma("unroll") for (int rep = 0; rep < REPS(3); ++rep) { if (rep) xcd_barrier(bar);
        for (int j = mj0; j < 16; j += G) meta_res_unit(lds, j, MIXM, (const bf16_t*)(ws + WS_WOUT), D, HM, HMB, SSPM);
        SchedDenseT<0, D / 256> S{M / 256, G, bx, (const char*)MIX, (const char*)(ws + WS_WOUT), (size_t)256 * D * 2, SSP};
        EpiRes<1> E{nullptr, HB, SSP, nullptr, ROWSUM};
        pg8::gemm_phase(lds, 2 * D, S, E);
    }
    SEAM(3);
    if (IN(4)) _Pragma("unroll") for (int rep = 0; rep < REPS(4); ++rep) { if (rep) xcd_barrier(bar);
        for (int j = mj0; j < 88; j += G) meta_ffnup_unit(lds, j, HMB, (const bf16_t*)(ws + WS_WGU), SSPM, ACTM);
        SchedDenseT<4, 2 * DFF / 256> S{M / 256, G, bx, (const char*)HB, (const char*)(ws + WS_WGU), (size_t)256 * D * 2, SSP};
        EpiSwiglu E{(bf16_t*)(ws + WS_ACT), SSP};
        pg8::gemm_phase(lds, 2 * D, S, E);
    }
    SEAM(4);
    if (IN(5)) {
        for (int j = mj0; j < 16; j += G) meta_res_unit(lds, j, ACTM, (const bf16_t*)(ws + WS_WD), DFF, HM, HMB, SSPM);
        SchedDenseT<0, D / 256> S{M / 256, G, bx, (const char*)(ws + WS_ACT), (const char*)(ws + WS_WD), (size_t)256 * DFF * 2, SSP};
        EpiRes<1> E{nullptr, HB, SSP, nullptr, ROWSUM};
        pg8::gemm_phase(lds, 2 * DFF, S, E);
    }
    SEAM(5);
    if (IN(6)) _Pragma("unroll") for (int rep = 0; rep < REPS(6); ++rep) { if (rep) xcd_barrier(bar);
        for (int j = mj0; j < 28; j += G) meta_inproj_unit(lds, j, HMB, (const bf16_t*)(ws + WS_WIN) + (size_t)DIN * D, SSPM, GT + 256, Zb);
        SchedDenseT<4, DIN / 256> S{M / 256, G, bx, (const char*)HB, (const char*)(ws + WS_WIN) + (size_t)DIN * D * 2, (size_t)256 * D * 2, SSP};
        LAS float* GL = (LAS float*)(lds + LDSCTL_OFF + 1024); if (tid < 256) GL[tid] = GT[256 + tid]; __syncthreads();
        EpiInProj E{Zb, SSP, GL};
        pg8::gemm_phase(lds, 2 * D, S, E);
    }
    SEAM(6);
    if (IN(7)) { mixer_phase<1>(a, lds, MISC, ctl, 0); if (REPS(7) > 1) { xcd_barrier(bar); mixer_phase<1>(a, lds, MISC, ctl, 1); } }
    SEAM(7);
    if (IN(8)) {
        SchedDenseT<0, D / 256> S{M / 256, G, bx, (const char*)MIX, (const char*)(ws + WS_WOUT) + (size_t)D * D * 2, (size_t)256 * D * 2, SSP};
        EpiRes<2> E{nullptr, HB, SSP, ws + WS_HB8, ROWSUM};
        pg8::gemm_phase(lds, 2 * D, S, E);
    }
    SEAM(8);
    float* LRS = (float*)(ms + MS_LRS); int* LTOK = (int*)(ms + MS_LTOK); float* LGATE = (float*)(ms + MS_LGATE);
    if (IN(9)) router_phase(lds, HB, (const bf16_t*)(ms + MS_WRB), SSP, LRS, LTOK, LGATE, (unsigned*)(ctl + CW_CNT), vcu, G);
    SEAM(9);
    volatile LAS unsigned* TMAP = (volatile LAS unsigned*)(lds + LDSCTL_OFF + 1024);
    if (hi > 10) moe_tables_fill((const unsigned*)(ctl + CW_CNT), MISC + 16, TMAP);
    const MoeTab MT0 = moe_tab(MISC + 16, TMAP, 0), MT1 = moe_tab(MISC + 16, TMAP, 1);
#define MT(k) ((k) ? MT1 : MT0)
    if (IN(10)) {
        SchedMoeUp S{MT(0), MT(1), G, bx, (const char*)(ws + WS_HB8), (const char*)(ws + WS_WEGU), LTOK, LRS};
        EpiSwigluMoe E{ws + WS_ACTE, LRS, MT(0), MT(1)};
        pg8::gemm_phase(lds, D, S, E);
    }
    SEAM(10);
    if (IN(11)) {
        SchedMoeDown S{MT(0), G, bx, 0, (const char*)(ws + WS_ACTE), (const char*)(ws + WS_WED), LTOK, LGATE, 0, 0}; S.init();
        EpiMoeDown<true> E{a.out, HB, LTOK, LGATE, MT(0), 0, (float*)(ws + WS_PART)};
        pg8::gemm_phase(lds, DFE, S, E);
    }
    SEAM(11);
    if (IN(12)) moe_reduce<true>(MT(0), 0, G, a.out, HB, LTOK, LGATE, (const float*)(ws + WS_PART), vcu * NWAVES + (tid >> 6), G * NWAVES, tid & 63);
    SEAM(12);
    if (IN(13)) {
        SchedMoeDown S{MT(1), G, bx, 1, (const char*)(ws + WS_ACTE + ACTE_BYTES), (const char*)(ws + WS_WED), LTOK, LGATE, 0, 0}; S.init();
        EpiMoeDown<false> E{a.out, HB, LTOK, LGATE, MT(1), 1, (float*)(ws + WS_PART)};
        pg8::gemm_phase(lds, DFE, S, E);
    }
    SEAM(13);
    if (IN(14)) moe_reduce<false>(MT(1), 1, G, a.out, HB, LTOK, LGATE, (const float*)(ws + WS_PART), vcu * NWAVES + (tid >> 6), G * NWAVES, tid & 63);
#undef MT
#undef IN
#undef SEAM
}

#ifdef DUMP_OFF
__global__ void dump_bf16(const bf16_t* src, float* out, size_t n) { for (size_t i = (size_t)blockIdx.x * blockDim.x + threadIdx.x; i < n; i += (size_t)gridDim.x * blockDim.x) out[i] = __uint_as_float((unsigned)src[i] << 16); }
#endif
extern "C" void kernel_launch(void* const* d_in, const int* in_sizes, int n_in, void* d_out, int out_size, void* d_ws, size_t ws_size, hipStream_t stream) {
    static int grid = 0;
    if (grid == 0) {
        if (n_in != 21 || in_sizes[0] != M * D || out_size != M * D || ws_size < WS_END) { fprintf(stderr, "kernel_launch: unexpected shapes (n_in %d, in0 %d, out %d, ws %zu < %zu); nothing launched\n", n_in, n_in > 0 ? in_sizes[0] : -1, out_size, ws_size, (size_t)WS_END); grid = -1; return; }
        int dev = 0, cus = 0, per_cu = 0;
        if (hipGetDevice(&dev) != hipSuccess || hipDeviceGetAttribute(&cus, hipDeviceAttributeMultiprocessorCount, dev) != hipSuccess) { grid = -1; return; }
        if (hipFuncSetAttribute((const void*)fwd_kernel, hipFuncAttributeMaxDynamicSharedMemorySize, LDS_BYTES) != hipSuccess) { fprintf(stderr, "kernel_launch: hipFuncSetAttribute failed\n"); grid = -1; return; }
        if (hipOccupancyMaxActiveBlocksPerMultiprocessor(&per_cu, (const void*)fwd_kernel, NTHREADS, LDS_BYTES) != hipSuccess || per_cu < 1) { fprintf(stderr, "kernel_launch: occupancy query reports %d workgroups per CU\n", per_cu); }
        (void)hipGetLastError();
        grid = cus;
    }
    if (grid < 0) return;
    if (hipMemsetAsync((char*)d_ws + WS_CTL, 0, CTL_ZERO_BYTES, stream) != hipSuccess) return;
    Args a{};
    for (int i = 0; i < 21; ++i) a.in[i] = (const float*)d_in[i];
    a.out = (float*)d_out; a.ws = (unsigned char*)d_ws;
#if MK_PER_PHASE
    for (int p = 0; p < N_PHASES; ++p) { a.ph_lo = p; a.ph_hi = p + 1; hipLaunchKernelGGL(fwd_kernel, dim3(grid), dim3(NTHREADS), LDS_BYTES, stream, a); }
#ifdef DUMP_OFF
    hipLaunchKernelGGL(dump_bf16, dim3(2048), dim3(256), 0, stream, (const bf16_t*)((const char*)d_ws + (DUMP_OFF)), (float*)d_out, (size_t)(DUMP_N));
#endif
#else
    a.ph_lo = 0; a.ph_hi = N_PHASES; hipLaunchKernelGGL(fwd_kernel, dim3(grid), dim3(NTHREADS), LDS_BYTES, stream, a);
#endif
}
```
